# Optimizing an MI355X kernel written in HIP

```python
import math
import jax
import jax.numpy as jnp
from jax import lax
import numpy as np

D_MODEL = 1024
BATCH = 2
SEQ = 8192
DEPTH = 2

GRID_W = 64
CTX_LEN = 256
EPS = 1e-6
ROPE_BASE = 10000.0
N_MOD = 9

A_HEADS = 4
A_QK = 32
A_V = 2 * A_QK
A_QCOLS = A_HEADS * 2 * A_QK
A_COLS = 2 * A_QCOLS + A_HEADS * A_V
A_SCALE = A_QK ** -0.5
Q_BLOCK = 128

B_HEADS = 4
B_KV_HEADS = 2
B_DIM = 64
WINDOW = 128
BLOCK = 128
B_QCOLS = B_HEADS * B_DIM
B_KCOLS = B_KV_HEADS * B_DIM
B_COLS = B_QCOLS + 2 * B_KCOLS
B_SCALE = B_DIM ** -0.5

C_HEADS = 8
C_HEAD_DIM = 64
C_INNER = C_HEADS * C_HEAD_DIM
C_GROUPS = 2
C_STATE = 64
C_CONV = 5
CHUNK = 128
C_XBC = C_INNER + 2 * C_GROUPS * C_STATE
C_COLS = C_INNER + C_XBC + 2 * C_HEADS

IN_COLS = A_COLS + B_COLS + C_COLS
MIX_WIDTH = A_HEADS * A_V + B_HEADS * B_DIM + C_INNER
D_FF = 2816

kernel_name = 'hybrid_dit_diffattn_swa_ssd_macaron'


def rms_norm(x, w):
    xf = x.astype(jnp.float32)
    y = xf * lax.rsqrt(jnp.mean(xf * xf, axis=-1, keepdims=True) + EPS)
    return (y * w.astype(jnp.float32)).astype(x.dtype)


def modulate(h, shift, scale):
    return h * (1 + scale) + shift


def adaln_chunks(mod):
    m = mod.reshape(-1, 1, N_MOD, D_MODEL)
    return [m[:, :, i] for i in range(N_MOD)]


def swiglu(h, w13, w2):
    g, u = jnp.split(h @ w13, 2, axis=-1)
    return (jax.nn.silu(g) * u) @ w2


def axial_rope_tables(seq_len, dim):
    rows = seq_len // GRID_W
    row = jnp.repeat(jnp.arange(rows, dtype=jnp.float32), GRID_W)
    col = jnp.tile(jnp.arange(GRID_W, dtype=jnp.float32), rows)
    quarter = dim // 4
    inv_freq = ROPE_BASE ** (-jnp.arange(quarter, dtype=jnp.float32) / quarter)
    ar = row[:, None] * inv_freq
    ac = col[:, None] * inv_freq
    ang = jnp.concatenate([ar, ar, ac, ac], axis=-1)
    return jnp.cos(ang), jnp.sin(ang)


def axial_rope(x, cos, sin):
    d = x.shape[-1]
    half, quarter = d // 2, d // 4

    def rot(u):
        return jnp.concatenate([-u[..., quarter:], u[..., :quarter]], axis=-1)

    xr = jnp.concatenate([rot(x[..., :half]), rot(x[..., half:])], axis=-1)
    shape = (1, x.shape[1]) + (1,) * (x.ndim - 3) + (d,)
    return x * cos.reshape(shape).astype(x.dtype) + xr * sin.reshape(shape).astype(x.dtype)


def diff_heads(p, qn, kn):
    b, t = p.shape[:2]
    q = rms_norm(p[..., :A_QCOLS].reshape(b, t, A_HEADS, 2, A_QK), qn)
    k = rms_norm(p[..., A_QCOLS:2 * A_QCOLS].reshape(b, t, A_HEADS, 2, A_QK), kn)
    v = p[..., 2 * A_QCOLS:].reshape(b, t, A_HEADS, A_V)
    return q, k, v


def diff_attend(q, k, v, lam, lam_init, subln):
    s = jnp.einsum('bqhcd,bkhcd->bhcqk', q, k).astype(jnp.float32) * A_SCALE
    p = jax.nn.softmax(s, axis=-1)
    a = p[:, :, 0] - lam * p[:, :, 1]
    o = jnp.einsum('bhqk,bkhd->bqhd', a.astype(v.dtype), v)
    return rms_norm(o, subln) * (1.0 - lam_init)


def diff_attend_latent(q, k_all, v_all, lam, lam_init, subln):
    b, s = q.shape[:2]
    nb = s // Q_BLOCK
    qb = jnp.moveaxis(q.reshape((b, nb, Q_BLOCK) + q.shape[2:]), 1, 0)
    ob = lax.map(lambda qi: diff_attend(qi, k_all, v_all, lam, lam_init, subln), qb)
    return jnp.moveaxis(ob, 0, 1).reshape(b, s, A_HEADS * A_V)


def gqa_heads(p, qn, kn):
    b, t = p.shape[:2]
    q = rms_norm(p[..., :B_QCOLS].reshape(b, t, B_HEADS, B_DIM), qn)
    k = rms_norm(p[..., B_QCOLS:B_QCOLS + B_KCOLS].reshape(b, t, B_KV_HEADS, B_DIM), kn)
    v = p[..., B_QCOLS + B_KCOLS:].reshape(b, t, B_KV_HEADS, B_DIM)
    return q, k, v


def window_attend_latent(q, k, v, k_ctx, v_ctx, sink):
    b, s, hq, d = q.shape
    g = hq // B_KV_HEADS
    nb = s // BLOCK
    qb = q.reshape(b, nb, BLOCK, B_KV_HEADS, g, d)
    pad = ((0, 0), (BLOCK, BLOCK), (0, 0), (0, 0))
    kp = jnp.pad(k, pad).reshape(b, nb + 2, BLOCK, B_KV_HEADS, d)
    vp = jnp.pad(v, pad).reshape(b, nb + 2, BLOCK, B_KV_HEADS, d)
    kw = jnp.concatenate([kp[:, :-2], kp[:, 1:-1], kp[:, 2:]], axis=2)
    vw = jnp.concatenate([vp[:, :-2], vp[:, 1:-1], vp[:, 2:]], axis=2)
    s_win = jnp.einsum('bnqhgd,bnkhd->bnhgqk', qb, kw).astype(jnp.float32) * B_SCALE
    qpos = jnp.arange(nb)[:, None] * BLOCK + jnp.arange(BLOCK)[None, :]
    kpos = (jnp.arange(nb)[:, None] - 1) * BLOCK + jnp.arange(3 * BLOCK)[None, :]
    valid = ((jnp.abs(kpos[:, None, :] - qpos[:, :, None]) <= WINDOW)
             & (kpos >= 0)[:, None, :] & (kpos < s)[:, None, :])
    s_win = jnp.where(valid[None, :, None, None], s_win, -jnp.inf)
    s_ctx = jnp.einsum('bnqhgd,bkhd->bnhgqk', qb, k_ctx).astype(jnp.float32) * B_SCALE
    sink_col = jnp.broadcast_to(sink.reshape(1, 1, B_KV_HEADS, g, 1, 1).astype(jnp.float32),
                                s_win.shape[:-1] + (1,))
    p = jax.nn.softmax(jnp.concatenate([s_win, s_ctx, sink_col], axis=-1), axis=-1)
    nw, nc = 3 * BLOCK, k_ctx.shape[1]
    p_win = p[..., :nw].astype(v.dtype)
    p_ctx = p[..., nw:nw + nc].astype(v.dtype)
    o = (jnp.einsum('bnhgqk,bnkhd->bnqhgd', p_win, vw)
         + jnp.einsum('bnhgqk,bkhd->bnqhgd', p_ctx, v_ctx))
    return o.reshape(b, s, hq * d)


def sink_attend_ctx(q, k, v, sink):
    b, t, hq, d = q.shape
    g = hq // B_KV_HEADS
    qg = q.reshape(b, t, B_KV_HEADS, g, d)
    s = jnp.einsum('bqhgd,bkhd->bhgqk', qg, k).astype(jnp.float32) * B_SCALE
    sink_col = jnp.broadcast_to(sink.reshape(1, B_KV_HEADS, g, 1, 1).astype(jnp.float32), s.shape[:-1] + (1,))
    p = jax.nn.softmax(jnp.concatenate([s, sink_col], axis=-1), axis=-1)[..., :-1]
    o = jnp.einsum('bhgqk,bkhd->bqhgd', p.astype(v.dtype), v)
    return o.reshape(b, t, hq * d)


def conv_centred(u, w, bias):
    ch = u.shape[-1]
    y = lax.conv_general_dilated(u, w.reshape(C_CONV, 1, ch).astype(u.dtype), window_strides=(1,),
                                 padding=[(C_CONV // 2, C_CONV // 2)],
                                 dimension_numbers=('NWC', 'WIO', 'NWC'), feature_group_count=ch)
    return jax.nn.silu(y + bias.astype(u.dtype))


def ssm_inputs(p, conv_w, conv_b):
    b, t = p.shape[:2]
    z = p[..., :C_INNER]
    xbc = conv_centred(p[..., C_INNER:C_INNER + C_XBC], conv_w, conv_b)
    xs = xbc[..., :C_INNER].reshape(b, t, C_HEADS, C_HEAD_DIM)
    bm = xbc[..., C_INNER:C_INNER + C_GROUPS * C_STATE].reshape(b, t, C_GROUPS, C_STATE)
    cm = xbc[..., C_INNER + C_GROUPS * C_STATE:].reshape(b, t, C_GROUPS, C_STATE)
    dt_raw = p[..., C_INNER + C_XBC:].reshape(b, t, 2, C_HEADS)
    return z, xs, bm, cm, dt_raw


def segsum(a):
    t = a.shape[-1]
    rep = jnp.broadcast_to(a[..., :, None], a.shape + (t,))
    cs = jnp.cumsum(jnp.where(jnp.tril(jnp.ones((t, t), bool), -1), rep, 0.0), axis=-2)
    return jnp.where(jnp.tril(jnp.ones((t, t), bool)), cs, -jnp.inf)


def ssd_scan(x, dt, A, bm, cm, init):
    b, t, h, pdim = x.shape
    g, n = bm.shape[2], bm.shape[3]
    r = h // g
    nc = t // CHUNK
    f32 = jnp.float32
    xdt = (x.astype(f32) * dt[..., None]).reshape(b, nc, CHUNK, g, r, pdim)
    a = jnp.moveaxis((dt * A).reshape(b, nc, CHUNK, g, r), 2, -1)
    a_cs = jnp.cumsum(a, axis=-1)
    bc = bm.astype(f32).reshape(b, nc, CHUNK, g, n)
    cc = cm.astype(f32).reshape(b, nc, CHUNK, g, n)
    decay_in = jnp.exp(segsum(a))
    cb = jnp.einsum('bclgn,bcsgn->bcgls', cc, bc)
    y_diag = jnp.einsum('bcgls,bcgrls,bcsgrp->bclgrp', cb, decay_in, xdt)
    decay_to_end = jnp.exp(a_cs[..., -1:] - a_cs)
    states = jnp.einsum('bclgn,bcgrl,bclgrp->bcgrpn', bc, decay_to_end, xdt)
    states = jnp.concatenate([init[:, None].astype(f32), states], axis=1)
    chunk_a = jnp.pad(jnp.moveaxis(a_cs[..., -1], 1, -1), ((0, 0), (0, 0), (0, 0), (1, 0)))
    decay_chunk = jnp.exp(segsum(chunk_a))
    new_states = jnp.einsum('bgrzc,bcgrpn->bzgrpn', decay_chunk, states)
    y_off = jnp.einsum('bclgn,bcgrpn,bcgrl->bclgrp', cc, new_states[:, :-1], jnp.exp(a_cs))
    y = (y_diag + y_off).reshape(b, t, h, pdim).astype(x.dtype)
    return y, new_states[:, -1]


def bidir_ssd(xs_c, b_c, c_c, dtr_c, xs_l, b_l, c_l, dtr_l, dt_bias, a_log):
    bsz = xs_l.shape[0]
    init = jnp.zeros((bsz, C_GROUPS, C_HEADS // C_GROUPS, C_HEAD_DIM, C_STATE), jnp.float32)
    y_ctx, y_lat = [], []
    for direction in range(2):
        if direction == 0:
            flip = lambda u: u
        else:
            flip = lambda u: jnp.flip(u, axis=1)
        A = -jnp.exp(a_log[direction].astype(jnp.float32))
        dt_c = jax.nn.softplus(dtr_c[..., direction, :].astype(jnp.float32) + dt_bias[direction].astype(jnp.float32))
        dt_l = jax.nn.softplus(dtr_l[..., direction, :].astype(jnp.float32) + dt_bias[direction].astype(jnp.float32))
        yc, h_ctx = ssd_scan(flip(xs_c), flip(dt_c), A, flip(b_c), flip(c_c), init)
        yl, _ = ssd_scan(flip(xs_l), flip(dt_l), A, flip(b_l), flip(c_l), h_ctx)
        y_ctx.append(flip(yc))
        y_lat.append(flip(yl))
    return y_ctx[0] + y_ctx[1], y_lat[0] + y_lat[1]


def ssm_output(y, xs, z, d_skip, gnorm):
    b, t = y.shape[:2]
    y = (y + d_skip[:, None].astype(y.dtype) * xs).reshape(b, t, C_INNER) * jax.nn.silu(z)
    y = rms_norm(y.reshape(b, t, C_GROUPS, C_INNER // C_GROUPS), gnorm.reshape(C_GROUPS, C_INNER // C_GROUPS))
    return y.reshape(b, t, C_INNER)


def hybrid_mixer(h_ctx, h_lat, cos_a, sin_a, cos_b, sin_b, w_in, qn_a, kn_a, lam, lam_init, subln_a,
                 qn_b, kn_b, sink_b, conv_w, conv_b, dt_bias, a_log, d_skip, gnorm_c, with_ctx_out):
    p_ctx = h_ctx @ w_in
    p_lat = h_lat @ w_in
    o1, o2 = A_COLS, A_COLS + B_COLS
    qa_c, ka_c, va_c = diff_heads(p_ctx[..., :o1], qn_a, kn_a)
    qa_l, ka_l, va_l = diff_heads(p_lat[..., :o1], qn_a, kn_a)
    qa_l = axial_rope(qa_l, cos_a, sin_a)
    ka_l = axial_rope(ka_l, cos_a, sin_a)
    ka_all = jnp.concatenate([ka_c, ka_l], axis=1)
    va_all = jnp.concatenate([va_c, va_l], axis=1)
    oa_l = diff_attend_latent(qa_l, ka_all, va_all, lam, lam_init, subln_a)
    qb_c, kb_c, vb_c = gqa_heads(p_ctx[..., o1:o2], qn_b, kn_b)
    qb_l, kb_l, vb_l = gqa_heads(p_lat[..., o1:o2], qn_b, kn_b)
    qb_l = axial_rope(qb_l, cos_b, sin_b)
    kb_l = axial_rope(kb_l, cos_b, sin_b)
    ob_l = window_attend_latent(qb_l, kb_l, vb_l, kb_c, vb_c, sink_b)
    z_c, xs_c, b_c, c_c, dtr_c = ssm_inputs(p_ctx[..., o2:], conv_w, conv_b)
    z_l, xs_l, b_l, c_l, dtr_l = ssm_inputs(p_lat[..., o2:], conv_w, conv_b)
    y_c, y_l = bidir_ssd(xs_c, b_c, c_c, dtr_c, xs_l, b_l, c_l, dtr_l, dt_bias, a_log)
    oc_l = ssm_output(y_l, xs_l, z_l, d_skip, gnorm_c)
    out_lat = jnp.concatenate([oa_l, ob_l, oc_l], axis=-1)
    if not with_ctx_out:
        return None, out_lat
    bsz, tc = h_ctx.shape[:2]
    oa_c = diff_attend(qa_c, ka_c, va_c, lam, lam_init, subln_a).reshape(bsz, tc, A_HEADS * A_V)
    ob_c = sink_attend_ctx(qb_c, kb_c, vb_c, sink_b)
    oc_c = ssm_output(y_c, xs_c, z_c, d_skip, gnorm_c)
    out_ctx = jnp.concatenate([oa_c, ob_c, oc_c], axis=-1)
    return out_ctx, out_lat


def setup_inputs(seed: int = 0) -> dict:
    key = jax.random.key(seed)
    ks = iter(jax.random.split(key, 40))
    L = DEPTH

    def nrm(shape, scale):
        return jax.random.normal(next(ks), shape, jnp.float32) * scale

    def gain(shape):
        return 1.0 + 0.02 * jax.random.normal(next(ks), shape, jnp.float32)

    x = nrm((BATCH, SEQ, D_MODEL), 1.0)
    c = nrm((BATCH, D_MODEL), 1.0)
    ctx = nrm((BATCH, CTX_LEN, D_MODEL), 1.0)
    c_ctx = nrm((D_MODEL,), 1.0)
    w_mod = nrm((L, D_MODEL, N_MOD * D_MODEL), 0.5 * D_MODEL ** -0.5)
    b_mod = nrm((L, N_MOD * D_MODEL), 0.02)
    norm_ffn1 = gain((L, D_MODEL))
    ffn1_w13 = nrm((L, D_MODEL, 2 * D_FF), D_MODEL ** -0.5)
    ffn1_w2 = nrm((L, D_FF, D_MODEL), D_FF ** -0.5)
    norm_mix = gain((L, D_MODEL))
    w_in = nrm((L, D_MODEL, IN_COLS), D_MODEL ** -0.5)
    w_out = nrm((L, MIX_WIDTH, D_MODEL), MIX_WIDTH ** -0.5)
    qn_a = gain((L, A_QK))
    kn_a = gain((L, A_QK))
    lam_q1 = nrm((L, A_QK), 0.1)
    lam_k1 = nrm((L, A_QK), 0.1)
    lam_q2 = nrm((L, A_QK), 0.1)
    lam_k2 = nrm((L, A_QK), 0.1)
    subln_a = gain((L, A_V))
    qn_b = gain((L, B_DIM))
    kn_b = gain((L, B_DIM))
    sink_b = nrm((L, B_HEADS), 0.5)
    conv_w = nrm((L, C_CONV, C_XBC), C_CONV ** -0.5)
    conv_b = nrm((L, C_XBC), 0.01)
    dt0 = jnp.exp(jax.random.uniform(next(ks), (L, 2, C_HEADS), jnp.float32, math.log(1e-3), math.log(1e-1)))
    dt_bias = dt0 + jnp.log(-jnp.expm1(-dt0))
    a_log = jnp.log(jax.random.uniform(next(ks), (L, 2, C_HEADS), jnp.float32, 1.0, 16.0))
    d_skip = gain((L, C_HEADS))
    gnorm_c = gain((L, C_INNER))
    norm_ffn2 = gain((L, D_MODEL))
    ffn2_w13 = nrm((L, D_MODEL, 2 * D_FF), D_MODEL ** -0.5)
    ffn2_w2 = nrm((L, D_FF, D_MODEL), D_FF ** -0.5)
    return {'x': x, 'c': c, 'ctx': ctx, 'c_ctx': c_ctx, 'w_mod': w_mod, 'b_mod': b_mod,
            'norm_ffn1': norm_ffn1, 'ffn1_w13': ffn1_w13, 'ffn1_w2': ffn1_w2,
            'norm_mix': norm_mix, 'w_in': w_in, 'w_out': w_out,
            'qn_a': qn_a, 'kn_a': kn_a, 'lam_q1': lam_q1, 'lam_k1': lam_k1, 'lam_q2': lam_q2, 'lam_k2': lam_k2,
            'subln_a': subln_a, 'qn_b': qn_b, 'kn_b': kn_b, 'sink_b': sink_b,
            'conv_w': conv_w, 'conv_b': conv_b, 'dt_bias': dt_bias, 'a_log': a_log, 'd_skip': d_skip,
            'gnorm_c': gnorm_c, 'norm_ffn2': norm_ffn2, 'ffn2_w13': ffn2_w13, 'ffn2_w2': ffn2_w2}


def reference(x, c, ctx, c_ctx, w_mod, b_mod, norm_ffn1, ffn1_w13, ffn1_w2, norm_mix, w_in, w_out,
              qn_a, kn_a, lam_q1, lam_k1, lam_q2, lam_k2, subln_a, qn_b, kn_b, sink_b,
              conv_w, conv_b, dt_bias, a_log, d_skip, gnorm_c, norm_ffn2, ffn2_w13, ffn2_w2):
    s = x.shape[1]
    cos_a, sin_a = axial_rope_tables(s, A_QK)
    cos_b, sin_b = axial_rope_tables(s, B_DIM)
    sc_lat = jax.nn.silu(c)
    sc_ctx = jax.nn.silu(c_ctx)
    xl, xc = x, ctx
    for l in range(DEPTH):
        last = l == DEPTH - 1
        ml = adaln_chunks(sc_lat @ w_mod[l] + b_mod[l])
        mc = adaln_chunks(sc_ctx @ w_mod[l] + b_mod[l])
        xl = xl + 0.5 * ml[2] * swiglu(modulate(rms_norm(xl, norm_ffn1[l]), ml[0], ml[1]), ffn1_w13[l], ffn1_w2[l])
        xc = xc + 0.5 * mc[2] * swiglu(modulate(rms_norm(xc, norm_ffn1[l]), mc[0], mc[1]), ffn1_w13[l], ffn1_w2[l])
        lam_init = 0.8 - 0.6 * math.exp(-0.3 * l)
        lam = (jnp.exp(jnp.sum(lam_q1[l].astype(jnp.float32) * lam_k1[l].astype(jnp.float32)))
               - jnp.exp(jnp.sum(lam_q2[l].astype(jnp.float32) * lam_k2[l].astype(jnp.float32))) + lam_init)
        h_ctx = modulate(rms_norm(xc, norm_mix[l]), mc[3], mc[4])
        h_lat = modulate(rms_norm(xl, norm_mix[l]), ml[3], ml[4])
        mix_c, mix_l = hybrid_mixer(h_ctx, h_lat, cos_a, sin_a, cos_b, sin_b, w_in[l], qn_a[l], kn_a[l], lam,
                                    lam_init, subln_a[l], qn_b[l], kn_b[l], sink_b[l], conv_w[l], conv_b[l],
                                    dt_bias[l], a_log[l], d_skip[l], gnorm_c[l], not last)
        xl = xl + ml[5] * (mix_l @ w_out[l])
        xl = xl + 0.5 * ml[8] * swiglu(modulate(rms_norm(xl, norm_ffn2[l]), ml[6], ml[7]), ffn2_w13[l], ffn2_w2[l])
        if not last:
            xc = xc + mc[5] * (mix_c @ w_out[l])
            xc = xc + 0.5 * mc[8] * swiglu(modulate(rms_norm(xc, norm_ffn2[l]), mc[6], mc[7]), ffn2_w13[l], ffn2_w2[l])
    return xl
```

```cpp
#include <hip/hip_runtime.h>
#include <hip/hip_cooperative_groups.h>
#include <cstdio>
namespace cg = cooperative_groups;

typedef __attribute__((ext_vector_type(8))) short bf16x8;
typedef __attribute__((ext_vector_type(4))) short s16x4;
typedef __attribute__((ext_vector_type(16))) float f32x16;
typedef __attribute__((ext_vector_type(2))) float f32x2;
typedef __attribute__((ext_vector_type(2))) __bf16 bf16x2_t;
typedef unsigned short u16;
typedef __attribute__((ext_vector_type(4))) unsigned u32x4;
#define DI __device__ __forceinline__
#define MFMA32(a, b, c) __builtin_amdgcn_mfma_f32_32x32x16_bf16((a), (b), (c), 0, 0, 0)

constexpr int TB = 8448, TR = 16896, DM = 1024, DFF = 2816, PST = 2560, NCTX = 256;
constexpr float LOG2E = 1.4426950408889634f;
constexpr float EPS = 1e-6f;

constexpr size_t al256(size_t x) { return (x + 255) & ~(size_t)255; }
constexpr size_t OFF_XC = 0;
constexpr size_t OFF_H = al256(OFF_XC + (size_t)512 * 1024 * 4);
constexpr size_t OFF_R1 = al256(OFF_H + (size_t)TR * 1024 * 2);
constexpr size_t OFF_DTRAW = al256(OFF_R1 + (size_t)TR * DFF * 2);
constexpr size_t OFF_QA = al256(OFF_DTRAW + (size_t)TR * 16 * 4);
constexpr size_t OFF_KA = al256(OFF_QA + (size_t)TR * 256 * 2);
constexpr size_t OFF_VAT = al256(OFF_KA + (size_t)TR * 256 * 2);
constexpr size_t OFF_QB = al256(OFF_VAT + (size_t)TR * 256 * 2);
constexpr size_t OFF_KB = al256(OFF_QB + (size_t)TR * 256 * 2);
constexpr size_t OFF_VBT = al256(OFF_KB + (size_t)TR * 128 * 2);
constexpr size_t OFF_Z = al256(OFF_VBT + (size_t)TR * 128 * 2);
constexpr size_t OFF_XS = al256(OFF_Z + (size_t)TR * 512 * 2);
constexpr size_t OFF_BM = al256(OFF_XS + (size_t)TR * 512 * 2);
constexpr size_t OFF_CM = al256(OFF_BM + (size_t)TR * 128 * 2);
constexpr size_t OFF_DT = al256(OFF_CM + (size_t)TR * 128 * 2);
constexpr size_t OFF_ATOT = al256(OFF_DT + (size_t)TR * 16 * 4);
constexpr size_t OFF_MODS = al256(OFF_ATOT + (size_t)32 * 66 * 4);
constexpr size_t OFF_MISC = al256(OFF_MODS + (size_t)2 * 3 * 9216 * 4);
constexpr size_t OFF_BAR = al256(OFF_MISC + 256);
constexpr size_t OFF_W13A = al256(OFF_BAR + 3456 * 4);
constexpr size_t OFF_W2A = al256(OFF_W13A + (size_t)5632 * 1024 * 2);
constexpr size_t OFF_WIN = al256(OFF_W2A + (size_t)1024 * 2816 * 2);
constexpr size_t OFF_WOUT = al256(OFF_WIN + (size_t)2688 * 1024 * 2);
constexpr size_t OFF_W13B = al256(OFF_WOUT + (size_t)1024 * 1024 * 2);
constexpr size_t OFF_W2B = al256(OFF_W13B + (size_t)5632 * 1024 * 2);
constexpr size_t WS_TOTAL = al256(OFF_W2B + (size_t)1024 * 2816 * 2);

struct Params {
  const float* in[31];
  float* out;
  char* ws;
};

DI unsigned pk2(float a, float b) { f32x2 v = {a, b}; return __builtin_bit_cast(unsigned, __builtin_convertvector(v, bf16x2_t)); }
DI u16 f2bf(float a) { return __builtin_bit_cast(u16, (__bf16)a); }
DI float bf2f(u16 h) { return __uint_as_float(((unsigned)h) << 16); }
DI float bflo(unsigned u) { return __uint_as_float(u << 16); }
DI float bfhi(unsigned u) { return __uint_as_float(u & 0xffff0000u); }
DI int opq(int x) { asm volatile("" : "+v"(x)); return x; }
DI int crow(int i, int hh) { return (i & 3) + 8 * (i >> 2) + 4 * hh; }
DI float fexp(float x) { return __builtin_amdgcn_exp2f(x * LOG2E); }
DI float fsilu(float x) { return x * __builtin_amdgcn_rcpf(1.0f + fexp(-x)); }
DI float wave_sum(float v) {
#pragma unroll
  for (int off = 32; off > 0; off >>= 1) v += __shfl_xor(v, off);
  return v;
}
DI bf16x8 pack8(const float* p) {
  uint4 u;
  u.x = pk2(p[0], p[1]); u.y = pk2(p[2], p[3]); u.z = pk2(p[4], p[5]); u.w = pk2(p[6], p[7]);
  return __builtin_bit_cast(bf16x8, u);
}
DI float* stream_row(const Params& p, int b, int i) {
  return (i < NCTX) ? (float*)(p.ws + OFF_XC) + (size_t)(b * NCTX + i) * DM : p.out + ((size_t)b * 8192 + (i - NCTX)) * DM;
}
DI const float* input_row(const Params& p, int b, int i) {
  return (i < NCTX) ? p.in[2] + (size_t)(b * NCTX + i) * DM : p.in[0] + ((size_t)b * 8192 + (i - NCTX)) * DM;
}


#define XB_TMO      128
#define XB_XCNT(j)  (256  + 64 * (j))
#define XB_XSUB(j)  (1280 + 64 * (j))
#define XB_XGEN(j)  (2304 + 64 * (j))
#define XB_TOP      3328
#define XB_TOPGEN   3392
#define XCD_BAR_WORDS 3456
#define XB_SPIN_CAP (1u << 18)
#define LAS __attribute__((address_space(3)))
DI unsigned xb_ld(unsigned* p)              { return __hip_atomic_load(p, __ATOMIC_RELAXED, __HIP_MEMORY_SCOPE_AGENT); }
DI unsigned xb_add(unsigned* p, unsigned v) { return __hip_atomic_fetch_add(p, v, __ATOMIC_RELAXED, __HIP_MEMORY_SCOPE_AGENT); }
DI unsigned xb_xcc_id() { return (unsigned)__builtin_amdgcn_s_getreg((3 << 11) | 20) & 0xFu; }
#define XB_SPIN(cond, bar) do { unsigned _sp = 0; while (cond) { __builtin_amdgcn_s_sleep(1); \
    if ((++_sp & 255u) == 0u) { if (xb_ld(&(bar)[XB_TMO])) break; if (_sp > XB_SPIN_CAP) { atomicAdd(&(bar)[XB_TMO], 1u); break; } } } } while (0)
struct XcdBarrier { unsigned* bar; unsigned x; volatile LAS unsigned* st; };
DI XcdBarrier xcd_barrier_post(unsigned* bar, volatile LAS unsigned* st) {
  XcdBarrier b; b.bar = bar; b.x = xb_xcc_id(); b.st = st;
  if (threadIdx.x == 0) (void)xb_add(&bar[XB_XCNT(b.x)], 1u);
  return b;
}
DI void xcd_barrier_complete(unsigned* bar, unsigned x, unsigned& nloc, unsigned& nx) {
  const unsigned G = gridDim.x * gridDim.y * gridDim.z;
  unsigned sum, cnt, mine, sp = 0u;
  for (;;) {
    sum = 0u; cnt = 0u; mine = 0u;
#pragma unroll
    for (unsigned j = 0; j < 16; ++j) { const unsigned c = xb_ld(&bar[XB_XCNT(j)]); sum += c; cnt += (c > 0u) ? 1u : 0u; mine = (j == x) ? c : mine; }
    if (sum == G) break;
    __builtin_amdgcn_s_sleep(1);
    if ((++sp & 255u) == 0u) { if (xb_ld(&bar[XB_TMO])) break; if (sp > XB_SPIN_CAP) { atomicAdd(&bar[XB_TMO], 1u); break; } }
  }
  nloc = mine > 0u ? mine : 1u; nx = cnt > 0u ? cnt : 1u;
}
DI void xcd_barrier(const XcdBarrier& b) {
  asm volatile("s_waitcnt vmcnt(0)" ::: "memory");
  __syncthreads();
  if (threadIdx.x == 0) {
    unsigned* bar = b.bar;
    __builtin_amdgcn_s_waitcnt(0);
    unsigned nloc = b.st[0], nx = b.st[1];
    if (nloc == 0u) { xcd_barrier_complete(bar, b.x, nloc, nx); b.st[0] = nloc; b.st[1] = nx; }
    const unsigned old = xb_add(&bar[XB_XSUB(b.x)], 1u);
    const unsigned gen = old / nloc;
    if (old + 1u == (gen + 1u) * nloc) {
      __builtin_amdgcn_fence(__ATOMIC_RELEASE, "agent");
      asm volatile("s_waitcnt vmcnt(0)" ::: "memory");
      const unsigned og = xb_add(&bar[XB_TOP], 1u);
      const unsigned tg = og / nx;
      if (og + 1u == (tg + 1u) * nx) xb_add(&bar[XB_TOPGEN], 1u);
      else XB_SPIN(xb_ld(&bar[XB_TOPGEN]) == tg, bar);
      __builtin_amdgcn_fence(__ATOMIC_ACQUIRE, "agent");
      xb_add(&bar[XB_XGEN(b.x)], 1u);
      asm volatile("s_waitcnt vmcnt(0)" ::: "memory");
    } else {
      XB_SPIN(xb_ld(&bar[XB_XGEN(b.x)]) == gen, bar);
      __builtin_amdgcn_fence(__ATOMIC_ACQUIRE, "agent");
      asm volatile("s_waitcnt vmcnt(0)" ::: "memory");
    }
  }
  __syncthreads();
}

DI void convert_tile(const float* __restrict__ src, u16* __restrict__ dst, int K, int N, int ntn, int idx, bool swiglu_perm, char* smem) {
  float* tile = (float*)smem;
  const int t = opq(threadIdx.x);
  const int kt = idx / ntn, nt = idx % ntn, k0 = kt * 64, n0 = nt * 64;
  {
    const int col = t & 63, r0 = t >> 6;
    const int n = n0 + col;
    float vv[16];
#pragma unroll
    for (int q = 0; q < 16; ++q) vv[q] = (n < N) ? __builtin_nontemporal_load(&src[(size_t)(k0 + r0 + 4 * q) * N + n]) : 0.0f;
#pragma unroll
    for (int q = 0; q < 16; ++q) tile[col * 65 + r0 + 4 * q] = vv[q];
  }
  __syncthreads();
  {
    const int kp = t & 31, nn0 = t >> 5;
#pragma unroll
    for (int j = 0; j < 8; ++j) {
      const int nn = nn0 + 8 * j, n = n0 + nn;
      int np = n;
      if (swiglu_perm) {
        if (n < DFF) np = (n >> 5) * 64 + (n & 31);
        else { int jj = n - DFF; np = (jj >> 5) * 64 + 32 + (jj & 31); }
      }
      unsigned v = pk2(tile[nn * 65 + 2 * kp], tile[nn * 65 + 2 * kp + 1]);
      *(unsigned*)(dst + (size_t)np * K + k0 + 2 * kp) = v;
    }
  }
  __syncthreads();
}

constexpr int CV_T0 = 1408, CV_T1 = CV_T0 + 704, CV_T2 = CV_T1 + 672, CV_T3 = CV_T2 + 256, CV_T4 = CV_T3 + 1408, CV_T5 = CV_T4 + 704;

DI void convert_item(const Params& p, int l, int idx, char* smem) {
  if (idx < CV_T0) convert_tile(p.in[7] + (size_t)l * 1024 * 5632, (u16*)(p.ws + OFF_W13A), 1024, 5632, 88, idx, true, smem);
  else if (idx < CV_T1) convert_tile(p.in[8] + (size_t)l * 2816 * 1024, (u16*)(p.ws + OFF_W2A), 2816, 1024, 16, idx - CV_T0, false, smem);
  else if (idx < CV_T2) convert_tile(p.in[10] + (size_t)l * 1024 * 2576, (u16*)(p.ws + OFF_WIN), 1024, 2576, 42, idx - CV_T1, false, smem);
  else if (idx < CV_T3) convert_tile(p.in[11] + (size_t)l * 1024 * 1024, (u16*)(p.ws + OFF_WOUT), 1024, 1024, 16, idx - CV_T2, false, smem);
  else if (idx < CV_T4) convert_tile(p.in[29] + (size_t)l * 1024 * 5632, (u16*)(p.ws + OFF_W13B), 1024, 5632, 88, idx - CV_T3, true, smem);
  else convert_tile(p.in[30] + (size_t)l * 2816 * 1024, (u16*)(p.ws + OFF_W2B), 2816, 1024, 16, idx - CV_T4, false, smem);
}

DI void mods_item(const Params& p, int idx, char* smem) {
  float* sv = (float*)smem;
  float* red = sv + 3072;
  const int t = opq(threadIdx.x);
  const int l = idx / 288, n0 = (idx % 288) * 32;
  for (int e = t; e < 3072; e += 256) {
    int v = e >> 10, k = e & 1023;
    float xv = (v < 2) ? p.in[1][v * 1024 + k] : p.in[3][k];
    sv[e] = fsilu(xv);
  }
  __syncthreads();
  const int c = t & 31, kg = t >> 5;
  const float* w = p.in[4] + (size_t)l * 1024 * 9216 + n0 + c;
  float a0 = 0.f, a1 = 0.f, a2 = 0.f;
#pragma unroll 32
  for (int k = kg * 128; k < kg * 128 + 128; ++k) {
    float wv = __builtin_nontemporal_load(&w[(size_t)k * 9216]);
    a0 += sv[k] * wv; a1 += sv[1024 + k] * wv; a2 += sv[2048 + k] * wv;
  }
  red[(kg * 3 + 0) * 32 + c] = a0; red[(kg * 3 + 1) * 32 + c] = a1; red[(kg * 3 + 2) * 32 + c] = a2;
  __syncthreads();
  if (t < 96) {
    int v = t >> 5, cc = t & 31;
    float s = p.in[5][l * 9216 + n0 + cc];
#pragma unroll
    for (int g = 0; g < 8; ++g) s += red[(g * 3 + v) * 32 + cc];
    ((float*)(p.ws + OFF_MODS))[(l * 3 + v) * 9216 + n0 + cc] = s;
  }
  __syncthreads();
}

DI void misc_item(const Params& p) {
  const int t_ = opq(threadIdx.x);
  if (t_ < 2) {
    const int l = t_;
    float s1 = 0.f, s2 = 0.f, mqa = 0.f, mka = 0.f;
    for (int i = 0; i < 32; ++i) {
      s1 += p.in[14][l * 32 + i] * p.in[15][l * 32 + i];
      s2 += p.in[16][l * 32 + i] * p.in[17][l * 32 + i];
      mqa = fmaxf(mqa, fabsf(p.in[12][l * 32 + i]));
      mka = fmaxf(mka, fabsf(p.in[13][l * 32 + i]));
    }
    float mqb = 0.f, mkb = 0.f;
    for (int i = 0; i < 64; ++i) {
      mqb = fmaxf(mqb, fabsf(p.in[19][l * 64 + i]));
      mkb = fmaxf(mkb, fabsf(p.in[20][l * 64 + i]));
    }
    float lam_init = 0.8f - 0.6f * expf(-0.3f * (float)l);
    float* m = (float*)(p.ws + OFF_MISC);
    m[l * 4 + 0] = expf(s1) - expf(s2) + lam_init;
    m[l * 4 + 1] = lam_init;
    m[l * 4 + 2] = 32.0f * mqa * mka * 0.17677669529663687f * LOG2E * 1.01f;
    m[l * 4 + 3] = 64.0f * mqb * mkb * 0.125f * LOG2E * 1.01f;
  }
}

DI void normmod_phase(const Params& p, int l, int which, int bid, int nb) {
  const float* nw = p.in[which == 0 ? 6 : (which == 1 ? 9 : 28)] + l * DM;
  const int t_ = opq(threadIdx.x);
  const int wave = t_ >> 6, lane = t_ & 63;
  u16* H = (u16*)(p.ws + OFF_H);
  const bool from_input = (l == 0 && which == 0);
  for (int R = bid * 4 + wave; R < TR; R += nb * 4) {
    const int b = R / TB, i = R % TB;
    const bool isctx = i < NCTX;
    const float* src = from_input ? input_row(p, b, i) : stream_row(p, b, i);
    const float* mod = (const float*)(p.ws + OFF_MODS) + (size_t)(l * 3 + (isctx ? 2 : b)) * 9216;
    const float* shift = mod + (which * 3) * DM;
    const float* scale = mod + (which * 3 + 1) * DM;
    float4 v[4];
    float ss = 0.f;
#pragma unroll
    for (int j = 0; j < 4; ++j) {
      v[j] = ((const float4*)src)[lane + 64 * j];
      ss += v[j].x * v[j].x + v[j].y * v[j].y + v[j].z * v[j].z + v[j].w * v[j].w;
    }
    ss = wave_sum(ss);
    const float rinv = rsqrtf(ss * (1.0f / DM) + EPS);
    if (from_input) {
      float* dstrow = stream_row(p, b, i);
#pragma unroll
      for (int j = 0; j < 4; ++j) ((float4*)dstrow)[lane + 64 * j] = v[j];
    }
#pragma unroll
    for (int j = 0; j < 4; ++j) {
      const int c4 = lane + 64 * j;
      float4 w4 = ((const float4*)nw)[c4], sh = ((const float4*)shift)[c4], sc = ((const float4*)scale)[c4];
      float y0 = v[j].x * rinv * w4.x * (1.0f + sc.x) + sh.x;
      float y1 = v[j].y * rinv * w4.y * (1.0f + sc.y) + sh.y;
      float y2 = v[j].z * rinv * w4.z * (1.0f + sc.z) + sh.z;
      float y3 = v[j].w * rinv * w4.w * (1.0f + sc.w) + sh.w;
      uint2 o; o.x = pk2(y0, y1); o.y = pk2(y2, y3);
      *(uint2*)(H + (size_t)R * DM + c4 * 4) = o;
    }
  }
}

constexpr int G_LD = 40, G_STAGE = 384 * G_LD;
DI void gemm_gload(u32x4 (&ra)[4], u32x4 (&rb)[2], const u16* __restrict__ Agt, const u16* __restrict__ Bgt, int K, int kt) {
#pragma unroll
  for (int j = 0; j < 4; ++j) ra[j] = *(const u32x4*)(Agt + (size_t)(64 * j) * K + kt * 32);
#pragma unroll
  for (int j = 0; j < 2; ++j) rb[j] = *(const u32x4*)(Bgt + (size_t)(64 * j) * K + kt * 32);
}
DI void gemm_sstore(const u32x4 (&ra)[4], const u32x4 (&rb)[2], u16* sAt, u16* sBt) {
#pragma unroll
  for (int j = 0; j < 4; ++j) *(u32x4*)(sAt + 64 * j * G_LD) = ra[j];
#pragma unroll
  for (int j = 0; j < 2; ++j) *(u32x4*)(sBt + 64 * j * G_LD) = rb[j];
}
template <bool SWAP>
DI void gemm_compute(f32x16 (&acc)[4][2], const u16* a_, const u16* b_, int wm, int wn, int r, int hh) {
#pragma unroll
  for (int kk = 0; kk < 2; ++kk) {
    bf16x8 af[4], bfr[2];
#pragma unroll
    for (int mi = 0; mi < 4; ++mi) af[mi] = *(const bf16x8*)(a_ + (wm * 128 + mi * 32 + r) * G_LD + kk * 16 + hh * 8);
#pragma unroll
    for (int ni = 0; ni < 2; ++ni) bfr[ni] = *(const bf16x8*)(b_ + (wn * 64 + ni * 32 + r) * G_LD + kk * 16 + hh * 8);
#pragma unroll
    for (int mi = 0; mi < 4; ++mi)
#pragma unroll
      for (int ni = 0; ni < 2; ++ni) acc[mi][ni] = SWAP ? MFMA32(bfr[ni], af[mi], acc[mi][ni]) : MFMA32(af[mi], bfr[ni], acc[mi][ni]);
  }
  __builtin_amdgcn_iglp_opt(0);
}
template <bool SWAP>
DI void gemm_tile_kloop(f32x16 (&acc)[4][2], const u16* __restrict__ A, const u16* __restrict__ Bt, int K, int mt, int nt, int k0, int k1,
                        char* smem, int t, int wm, int wn, int r, int hh) {
#pragma unroll
  for (int a = 0; a < 4; ++a)
#pragma unroll
    for (int c = 0; c < 2; ++c)
#pragma unroll
      for (int i = 0; i < 16; ++i) acc[a][c][i] = 0.f;
  u16* sm = (u16*)smem;
  const int lrow = t >> 2, lkc = (t & 3) * 8;
  const u16* Agt = A + (size_t)(mt * 256 + lrow) * K + lkc;
  const u16* Bgt = Bt + (size_t)(nt * 128 + lrow) * K + lkc;
  u16* sAt = sm + lrow * G_LD + lkc;
  u16* sBt = sm + 256 * G_LD + lrow * G_LD + lkc;
  u32x4 ra0[4], rb0[2], ra1[4], rb1[2];
  gemm_gload(ra0, rb0, Agt, Bgt, K, k0);
  gemm_sstore(ra0, rb0, sAt, sBt);
  gemm_gload(ra1, rb1, Agt, Bgt, K, k0 + 1);
  __syncthreads();
  for (int kt = k0; kt < k1; kt += 2) {
    gemm_compute<SWAP>(acc, sm, sm + 256 * G_LD, wm, wn, r, hh);
    gemm_sstore(ra1, rb1, sAt + G_STAGE, sBt + G_STAGE);
    gemm_gload(ra0, rb0, Agt, Bgt, K, min(kt + 2, k1 - 1));
    __syncthreads();
    gemm_compute<SWAP>(acc, sm + G_STAGE, sm + G_STAGE + 256 * G_LD, wm, wn, r, hh);
    gemm_sstore(ra0, rb0, sAt, sBt);
    gemm_gload(ra1, rb1, Agt, Bgt, K, min(kt + 3, k1 - 1));
    __syncthreads();
  }
}

DI void gemm_tile_kloop_pf(f32x16 (&acc)[4][2], const u16* __restrict__ A, const u16* __restrict__ Bt, int K, int mt, int nt, int nk,
                           char* smem, int t, int wm, int wn, int r, int hh, u32x4 (&ra0)[4], u32x4 (&rb0)[2]) {
#pragma unroll
  for (int a = 0; a < 4; ++a)
#pragma unroll
    for (int c = 0; c < 2; ++c)
#pragma unroll
      for (int i = 0; i < 16; ++i) acc[a][c][i] = 0.f;
  u16* sm = (u16*)smem;
  const int lrow = t >> 2, lkc = (t & 3) * 8;
  const u16* Agt = A + (size_t)(mt * 256 + lrow) * K + lkc;
  const u16* Bgt = Bt + (size_t)(nt * 128 + lrow) * K + lkc;
  u16* sAt = sm + lrow * G_LD + lkc;
  u16* sBt = sm + 256 * G_LD + lrow * G_LD + lkc;
  u32x4 ra1[4], rb1[2];
  gemm_sstore(ra0, rb0, sAt, sBt);
  gemm_gload(ra1, rb1, Agt, Bgt, K, 1);
  __syncthreads();
  for (int kt = 0; kt < nk; kt += 2) {
    gemm_compute<false>(acc, sm, sm + 256 * G_LD, wm, wn, r, hh);
    gemm_sstore(ra1, rb1, sAt + G_STAGE, sBt + G_STAGE);
    gemm_gload(ra0, rb0, Agt, Bgt, K, min(kt + 2, nk - 1));
    __syncthreads();
    gemm_compute<false>(acc, sm + G_STAGE, sm + G_STAGE + 256 * G_LD, wm, wn, r, hh);
    gemm_sstore(ra0, rb0, sAt, sBt);
    gemm_gload(ra1, rb1, Agt, Bgt, K, min(kt + 3, nk - 1));
    __syncthreads();
  }
}

DI void st4bf_(u16* ptr, float a, float b, float c, float d) { uint2 u; u.x = pk2(a, b); u.y = pk2(c, d); *(uint2*)ptr = u; }
DI void epi_win(const Params& p, int l, f32x16 (&acc)[4][2], int mt, int nt, int wm, int wn, int r_, int hh_) {
  const int r = opq(r_), hh = opq(hh_);
  const int b = (mt * 256) / TB, i0 = (mt * 256) % TB;
  const bool isctx = i0 < NCTX;
#pragma unroll
  for (int mi = 0; mi < 4; ++mi) {
    const int itok = i0 + wm * 128 + mi * 32 + r;
    const size_t R = (size_t)b * TB + itok;
    const int tpos = itok - NCTX;
    const float rowp = (float)(tpos >> 6), colp = (float)(tpos & 63);
    if (nt < 4) {
      const bool isq = nt < 2;
      const float* w = p.in[isq ? 12 : 13] + l * 32;
      u16* dst = (u16*)(p.ws + (isq ? OFF_QA : OFF_KA)) + R * 256 + (nt & 1) * 128 + wn * 64;
      const float osc = isq ? 0.17677669529663687f * LOG2E : 1.0f;
#pragma unroll
      for (int ni = 0; ni < 2; ++ni) {
        f32x16& v = acc[mi][ni];
        float ss = 0.f;
#pragma unroll
        for (int i = 0; i < 16; ++i) ss += v[i] * v[i];
        ss += __shfl_xor(ss, 32);
        const float rinv = rsqrtf(ss * (1.0f / 32) + EPS);
#pragma unroll
        for (int i = 0; i < 16; ++i) v[i] *= rinv * w[crow(i, hh)];
        if (!isctx) {
#pragma unroll
          for (int g2 = 0; g2 < 2; ++g2)
#pragma unroll
            for (int e = 0; e < 4; ++e) {
              const int i = 8 * g2 + e;
              const float idx = (float)(e + 4 * hh);
              const float ang = (g2 == 0 ? rowp : colp) * __builtin_amdgcn_exp2f(-idx * (13.287712379549449f / 8));
              const float c = __cosf(ang), s = __sinf(ang);
              const float a = v[i], bb = v[i + 4];
              v[i] = a * c - bb * s;
              v[i + 4] = bb * c + a * s;
            }
        }
#pragma unroll
        for (int g = 0; g < 4; ++g) st4bf_(dst + ni * 32 + 8 * g + 4 * hh, v[4 * g] * osc, v[4 * g + 1] * osc, v[4 * g + 2] * osc, v[4 * g + 3] * osc);
      }
    } else if (nt < 6) {
      u16* VAT = (u16*)(p.ws + OFF_VAT);
#pragma unroll
      for (int ni = 0; ni < 2; ++ni)
#pragma unroll
        for (int i = 0; i < 16; ++i) {
          const int ch = (nt - 4) * 128 + wn * 64 + ni * 32 + crow(i, hh);
          VAT[((size_t)b * 256 + ch) * TB + itok] = f2bf(acc[mi][ni][i]);
        }
    } else if (nt < 9) {
      const bool isq = nt < 8;
      const float* w = p.in[isq ? 19 : 20] + l * 64;
      u16* dst = isq ? (u16*)(p.ws + OFF_QB) + R * 256 + ((nt - 6) * 2 + wn) * 64 : (u16*)(p.ws + OFF_KB) + R * 128 + wn * 64;
      const float osc = isq ? 0.125f * LOG2E : 1.0f;
      f32x16 (&v)[2] = acc[mi];
      float ss = 0.f;
#pragma unroll
      for (int ni = 0; ni < 2; ++ni)
#pragma unroll
        for (int i = 0; i < 16; ++i) ss += v[ni][i] * v[ni][i];
      ss += __shfl_xor(ss, 32);
      const float rinv = rsqrtf(ss * (1.0f / 64) + EPS);
#pragma unroll
      for (int ni = 0; ni < 2; ++ni)
#pragma unroll
        for (int i = 0; i < 16; ++i) v[ni][i] *= rinv * w[ni * 32 + crow(i, hh)];
      if (!isctx) {
#pragma unroll
        for (int ni = 0; ni < 2; ++ni)
#pragma unroll
          for (int i = 0; i < 8; ++i) {
            const float idx = (float)crow(i, hh);
            const float ang = (ni == 0 ? rowp : colp) * __builtin_amdgcn_exp2f(-idx * (13.287712379549449f / 16));
            const float c = __cosf(ang), s = __sinf(ang);
            const float a = v[ni][i], bb = v[ni][i + 8];
            v[ni][i] = a * c - bb * s;
            v[ni][i + 8] = bb * c + a * s;
          }
      }
#pragma unroll
      for (int ni = 0; ni < 2; ++ni)
#pragma unroll
        for (int g = 0; g < 4; ++g)
          st4bf_(dst + ni * 32 + 8 * g + 4 * hh, v[ni][4 * g] * osc, v[ni][4 * g + 1] * osc, v[ni][4 * g + 2] * osc, v[ni][4 * g + 3] * osc);
    } else if (nt == 9) {
      u16* VBT = (u16*)(p.ws + OFF_VBT);
#pragma unroll
      for (int ni = 0; ni < 2; ++ni)
#pragma unroll
        for (int i = 0; i < 16; ++i) {
          const int ch = wn * 64 + ni * 32 + crow(i, hh);
          VBT[((size_t)b * 128 + ch) * TB + itok] = f2bf(acc[mi][ni][i]);
        }
    } else if (nt < 20) {
      u16* dst = (nt < 14) ? (u16*)(p.ws + OFF_Z) + R * 512 + (nt - 10) * 128 + wn * 64
                           : (u16*)(p.ws + OFF_R1) + R * 768 + (nt - 14) * 128 + wn * 64;
#pragma unroll
      for (int ni = 0; ni < 2; ++ni)
#pragma unroll
        for (int g = 0; g < 4; ++g)
          st4bf_(dst + ni * 32 + 8 * g + 4 * hh, acc[mi][ni][4 * g], acc[mi][ni][4 * g + 1], acc[mi][ni][4 * g + 2], acc[mi][ni][4 * g + 3]);
    } else {
      if (wn == 0) {
        float* DT = (float*)(p.ws + OFF_DT);
#pragma unroll
        for (int i = 0; i < 8; ++i) {
          const int c = crow(i, hh);
          const float x = acc[mi][0][i] + p.in[24][l * 16 + c];
          const float y = fexp(x);
          DT[R * 16 + c] = (x > 15.f) ? x : ((y < 1e-3f) ? (y - 0.5f * y * y) : logf(1.0f + y));
        }
      }
    }
    __builtin_amdgcn_sched_barrier(0);
  }
}

template <int EPI>
DI void gemm_phase(const Params& p, int l, const u16* __restrict__ A, int K, const u16* __restrict__ Bt, int ntn,
                   float coef, int gate_chunk, char* smem, int bid, int nb) {
  const int t = opq(threadIdx.x), lane = t & 63, wave = t >> 6, wm = wave >> 1, wn = wave & 1, r = lane & 31, hh = lane >> 5;
  const int ntiles = 66 * ntn;
  const int nk = K / 32;
  const int xcd = bid & 7, jloc = bid >> 3, chunk = nb >> 3;
  f32x16 acc[4][2];
  if (EPI == 1) {
    const int nk2 = nk >> 1;
    const long U = (long)ntiles * nk2;
    const int ord = xcd * chunk + jloc;
    long u = U * ord / nb;
    const long u_end = U * (ord + 1) / nb;
    while (u < u_end) {
      const int tile = (int)(u / nk2), kk0 = (int)(u % nk2);
      const int cnt = (int)min((long)(nk2 - kk0), u_end - u);
      const int mt = tile / ntn, nt = tile % ntn;
      gemm_tile_kloop<false>(acc, A, Bt, K, mt, nt, kk0 * 2, (kk0 + cnt) * 2, smem, t, wm, wn, r, hh);
      const int b = (mt * 256) / TB, i0 = (mt * 256) % TB;
      const bool isctx = i0 < NCTX;
      const float* gate = (const float*)(p.ws + OFF_MODS) + (size_t)(l * 3 + (isctx ? 2 : b)) * 9216 + gate_chunk * DM;
      float* tbase = stream_row(p, b, i0);
      const int re = opq(r), he = opq(hh);
#pragma unroll
      for (int ni = 0; ni < 2; ++ni) {
        const int col = nt * 128 + wn * 64 + ni * 32 + re;
        const float gc = coef * gate[col];
        const unsigned voff = (unsigned)((wm * 128 + 4 * he) * DM + col);
#pragma unroll
        for (int mi = 0; mi < 4; ++mi)
#pragma unroll
          for (int i = 0; i < 16; ++i)
            unsafeAtomicAdd(tbase + (voff + (unsigned)((mi * 32 + (i & 3) + 8 * (i >> 2)) * DM)), gc * acc[mi][ni][i]);
      }
      u += cnt;
    }
    return;
  }
  if (EPI == 0) {
    const int lrow = t >> 2, lkc = (t & 3) * 8;
    u32x4 pa[4], pb[2];
    int cidx = xcd, mt = 0, nt = 0;
    bool have = (cidx * chunk < ntiles) && (cidx * chunk + jloc < ntiles);
    if (have) {
      const int o = cidx * chunk + jloc;
      if (o < 64 * ntn) { const int grp = o / (8 * ntn), within = o % (8 * ntn); nt = within >> 3; mt = grp * 8 + (within & 7); }
      else { const int within = o - 64 * ntn; nt = within >> 1; mt = 64 + (within & 1); }
      gemm_gload(pa, pb, A + (size_t)(mt * 256 + lrow) * K + lkc, Bt + (size_t)(nt * 128 + lrow) * K + lkc, K, 0);
    }
    while (have) {
      gemm_tile_kloop_pf(acc, A, Bt, K, mt, nt, nk, smem, t, wm, wn, r, hh, pa, pb);
      const int cmt = mt, cnt_ = nt;
      cidx += 8;
      have = (cidx * chunk < ntiles) && (cidx * chunk + jloc < ntiles);
      if (have) {
        const int o = cidx * chunk + jloc;
        if (o < 64 * ntn) { const int grp = o / (8 * ntn), within = o % (8 * ntn); nt = within >> 3; mt = grp * 8 + (within & 7); }
        else { const int within = o - 64 * ntn; nt = within >> 1; mt = 64 + (within & 1); }
        gemm_gload(pa, pb, A + (size_t)(mt * 256 + lrow) * K + lkc, Bt + (size_t)(nt * 128 + lrow) * K + lkc, K, 0);
      }
      u16* tbase = (u16*)(p.ws + OFF_R1) + (size_t)(cmt * 256) * DFF;
      const int re = opq(r), he = opq(hh);
      const unsigned voff = (unsigned)((wm * 128 + 4 * he) * DFF + (cnt_ * 128 + wn * 64) / 2 + re);
#pragma unroll
      for (int mi = 0; mi < 4; ++mi)
#pragma unroll
        for (int i = 0; i < 16; ++i) {
          const float g = acc[mi][0][i], u = acc[mi][1][i];
          tbase[voff + (unsigned)((mi * 32 + (i & 3) + 8 * (i >> 2)) * DFF)] = f2bf(fsilu(g) * u);
        }
    }
    return;
  }
  for (int cidx = xcd; cidx * chunk < ntiles; cidx += 8) {
    const int o = cidx * chunk + jloc;
    if (o >= ntiles) break;
    int mt, nt;
    if (o < 64 * ntn) { const int grp = o / (8 * ntn), within = o % (8 * ntn); nt = within >> 3; mt = grp * 8 + (within & 7); }
    else { const int within = o - 64 * ntn; nt = within >> 1; mt = 64 + (within & 1); }
    gemm_tile_kloop<EPI == 2>(acc, A, Bt, K, mt, nt, 0, nk, smem, t, wm, wn, r, hh);
    const int row_base = mt * 256 + wm * 128;
    if (EPI == 0) {
      u16* tbase = (u16*)(p.ws + OFF_R1) + (size_t)(mt * 256) * DFF;
      const int re = opq(r), he = opq(hh);
      const unsigned voff = (unsigned)((wm * 128 + 4 * he) * DFF + (nt * 128 + wn * 64) / 2 + re);
#pragma unroll
      for (int mi = 0; mi < 4; ++mi)
#pragma unroll
        for (int i = 0; i < 16; ++i) {
          const float g = acc[mi][0][i], u = acc[mi][1][i];
          tbase[voff + (unsigned)((mi * 32 + (i & 3) + 8 * (i >> 2)) * DFF)] = f2bf(fsilu(g) * u);
        }
    } else {
      epi_win(p, l, acc, mt, nt, wm, wn, r, hh);
    }
  }
}

DI void cv4bf(uint2 u, float (&v)[4]) { v[0] = bflo(u.x); v[1] = bfhi(u.x); v[2] = bflo(u.y); v[3] = bfhi(u.y); }
DI void ld4bf(const u16* ptr, float (&v)[4]) { cv4bf(*(const uint2*)ptr, v); }
DI void st4bf(u16* ptr, const float (&v)[4]) {
  uint2 u; u.x = pk2(v[0], v[1]); u.y = pk2(v[2], v[3]);
  *(uint2*)ptr = u;
}
DI void postproc_phase(const Params& p, int l, int bid, int nb) {
  const int t_ = opq(threadIdx.x);
  const int wave = t_ >> 6, lane = t_ & 63;
  const u16* XR = (const u16*)(p.ws + OFF_R1);
  u16* XS = (u16*)(p.ws + OFF_XS); u16* BM = (u16*)(p.ws + OFF_BM); u16* CM = (u16*)(p.ws + OFF_CM);
  const float* conv_w = p.in[22] + (size_t)l * 5 * 768; const float* conv_b = p.in[23] + l * 768;
  float4 cw[3][5], cb[3];
#pragma unroll
  for (int pass = 0; pass < 3; ++pass) {
    cb[pass] = *(const float4*)(conv_b + pass * 256 + lane * 4);
#pragma unroll
    for (int j = 0; j < 5; ++j) cw[pass][j] = *(const float4*)(conv_w + j * 768 + pass * 256 + lane * 4);
  }
  for (int R = bid * 4 + wave; R < TR; R += nb * 4) {
    const int b = R / TB, i = R % TB;
    const bool isctx = i < NCTX;
    uint2 ucv[3][5];
#pragma unroll
    for (int j = 0; j < 5; ++j) {
      const int ii = i + j - 2;
      const bool valid = isctx ? (ii >= 0 && ii < NCTX) : (ii >= NCTX && ii < TB);
      const u16* src = XR + (size_t)(b * TB + (valid ? ii : i)) * 768 + lane * 4;
#pragma unroll
      for (int pass = 0; pass < 3; ++pass) {
        uint2 u = *(const uint2*)(src + pass * 256);
        if (!valid) { u.x = 0u; u.y = 0u; }
        ucv[pass][j] = u;
      }
    }
#pragma unroll
    for (int pass = 0; pass < 3; ++pass) {
      float acc[4] = {cb[pass].x, cb[pass].y, cb[pass].z, cb[pass].w};
#pragma unroll
      for (int j = 0; j < 5; ++j) {
        float xv[4];
        cv4bf(ucv[pass][j], xv);
        acc[0] += xv[0] * cw[pass][j].x; acc[1] += xv[1] * cw[pass][j].y; acc[2] += xv[2] * cw[pass][j].z; acc[3] += xv[3] * cw[pass][j].w;
      }
#pragma unroll
      for (int e = 0; e < 4; ++e) acc[e] = fsilu(acc[e]);
      if (pass < 2) st4bf(XS + (size_t)R * 512 + pass * 256 + lane * 4, acc);
      else if (lane < 32) st4bf(BM + (size_t)R * 128 + lane * 4, acc);
      else st4bf(CM + (size_t)R * 128 + (lane - 32) * 4, acc);
    }
  }
}

template <int DQK, bool MASK>
DI void attn_stream(const bf16x8* bq, const u16* __restrict__ Kp, int ldk, const u16* __restrict__ VTp, int ldvt, int kt0, int kt1,
                    int qpos, float m2, f32x16* O, float& lsum, int lane) {
  const int r = lane & 31, hh = lane >> 5;
#pragma unroll 2
  for (int kt = kt0; kt < kt1; ++kt) {
    f32x16 s;
#pragma unroll
    for (int i = 0; i < 16; ++i) s[i] = 0.f;
#pragma unroll
    for (int ks = 0; ks < DQK / 16; ++ks) {
      bf16x8 ka = *(const bf16x8*)(Kp + (size_t)(kt * 32 + r) * ldk + ks * 16 + hh * 8);
      s = MFMA32(ka, bq[ks], s);
    }
    float pr[16];
#pragma unroll
    for (int i = 0; i < 16; ++i) {
      float x = s[i] - m2;
      float e = __builtin_amdgcn_exp2f(x);
      if (MASK) {
        const int kpos = kt * 32 + crow(i, hh);
        const int dd = kpos - qpos;
        if (dd > 128 || dd < -128) e = 0.f;
      }
      pr[i] = e;
      lsum += e;
    }
#pragma unroll
    for (int s2 = 0; s2 < 2; ++s2) {
      bf16x8 pf = pack8(pr + 8 * s2);
#pragma unroll
      for (int dt = 0; dt < 2; ++dt) {
        const u16* vp = VTp + (size_t)(dt * 32 + r) * ldvt + kt * 32 + 16 * s2 + 4 * hh;
        s16x4 lo = *(const s16x4*)vp;
        s16x4 hi = *(const s16x4*)(vp + 8);
        bf16x8 vf = __builtin_shufflevector(lo, hi, 0, 1, 2, 3, 4, 5, 6, 7);
        O[dt] = MFMA32(vf, pf, O[dt]);
      }
    }
  }
}

constexpr int AK_LD = 72, AV_LD = 68, A_STAGE = 64 * AK_LD + 64 * AV_LD;
DI void attnA_gload(u32x4 (&rk)[2], u32x4 (&rv)[2], const u16* __restrict__ Kt, const u16* __restrict__ Vt, int kt) {
#pragma unroll
  for (int j = 0; j < 2; ++j) {
    rk[j] = *(const u32x4*)(Kt + (size_t)(kt * 64 + 32 * j) * 256);
    rv[j] = *(const u32x4*)(Vt + (size_t)(32 * j) * TB + kt * 64);
  }
}
DI void attnA_sstore(const u32x4 (&rk)[2], const u32x4 (&rv)[2], u16* sKt, u16* sVt) {
#pragma unroll
  for (int j = 0; j < 2; ++j) {
    *(u32x4*)(sKt + 32 * j * AK_LD) = rk[j];
    uint2 lo, hi; lo.x = rv[j].x; lo.y = rv[j].y; hi.x = rv[j].z; hi.y = rv[j].w;
    *(uint2*)(sVt + 32 * j * AV_LD) = lo;
    *(uint2*)(sVt + 32 * j * AV_LD + 4) = hi;
  }
}
DI void attnA_compute(const u16* sK, const u16* sV, const bf16x8 (&bq)[2][2], f32x16 (&O)[2][2], float (&ls)[2], float m2, int r, int hh) {
  bf16x8 pf[2][2][2];
  float one = 1.0f;
  asm("" : "+v"(one));
#pragma unroll
  for (int sub = 0; sub < 2; ++sub)
#pragma unroll
    for (int c = 0; c < 2; ++c) {
      f32x16 s;
#pragma unroll
      for (int i = 0; i < 16; ++i) s[i] = -m2;
#pragma unroll
      for (int ks = 0; ks < 2; ++ks) {
        bf16x8 ka = *(const bf16x8*)(sK + (sub * 32 + r) * AK_LD + c * 32 + ks * 16 + hh * 8);
        s = MFMA32(ka, bq[c][ks], s);
      }
      float pr[16];
#pragma unroll
      for (int i = 0; i < 16; ++i) {
        pr[i] = __builtin_amdgcn_exp2f(s[i]);
        if (c == 0) ls[0] += pr[i]; else ls[1] = __builtin_fmaf(pr[i], one, ls[1]);
      }
      pf[c][sub][0] = pack8(pr);
      pf[c][sub][1] = pack8(pr + 8);
    }
#pragma unroll
  for (int sub = 0; sub < 2; ++sub)
#pragma unroll
    for (int s2 = 0; s2 < 2; ++s2)
#pragma unroll
      for (int dt = 0; dt < 2; ++dt) {
        const u16* vp = sV + (dt * 32 + r) * AV_LD + sub * 32 + 16 * s2 + 4 * hh;
        s16x4 lo = *(const s16x4*)vp;
        s16x4 hi = *(const s16x4*)(vp + 8);
        bf16x8 vf = __builtin_shufflevector(lo, hi, 0, 1, 2, 3, 4, 5, 6, 7);
#pragma unroll
        for (int c = 0; c < 2; ++c) O[c][dt] = MFMA32(vf, pf[c][sub][s2], O[c][dt]);
      }
}
DI void attnA_item(const Params& p, int l, int b, int h, int qrow0, int nkeys, char* smem) {
  const int t = opq(threadIdx.x);
  const int lane = t & 63, wave = t >> 6, r = lane & 31, hh = lane >> 5;
  const u16* QA = (const u16*)(p.ws + OFF_QA); const u16* KA = (const u16*)(p.ws + OFF_KA); const u16* VAT = (const u16*)(p.ws + OFF_VAT);
  u16* MIX = (u16*)(p.ws + OFF_H);
  const float* misc = (const float*)(p.ws + OFF_MISC);
  const float lam = misc[l * 4 + 0], lam_init = misc[l * 4 + 1], m2 = misc[l * 4 + 2];
  const int i = qrow0 + wave * 32 + r;
  const size_t R = (size_t)b * TB + i;
  bf16x8 bq[2][2];
#pragma unroll
  for (int c = 0; c < 2; ++c)
#pragma unroll
    for (int ks = 0; ks < 2; ++ks) bq[c][ks] = *(const bf16x8*)(QA + R * 256 + h * 64 + c * 32 + ks * 16 + hh * 8);
  f32x16 O[2][2];
#pragma unroll
  for (int c = 0; c < 2; ++c)
#pragma unroll
    for (int d = 0; d < 2; ++d)
#pragma unroll
      for (int k = 0; k < 16; ++k) O[c][d][k] = 0.f;
  float ls[2] = {0.f, 0.f};
  const int srow = t >> 3, sch = (t & 7) * 8;
  const u16* Kt = KA + ((size_t)b * TB + srow) * 256 + h * 64 + sch;
  const u16* Vt = VAT + ((size_t)b * 256 + h * 64 + srow) * TB + sch;
  u16* sm = (u16*)smem;
  u16* sKt = sm + srow * AK_LD + sch;
  u16* sVt = sm + 64 * AK_LD + srow * AV_LD + sch;
  const int nt = nkeys / 64;
  u32x4 rk0[2], rv0[2], rk1[2], rv1[2];
  __syncthreads();
  attnA_gload(rk0, rv0, Kt, Vt, 0);
  attnA_sstore(rk0, rv0, sKt, sVt);
  attnA_gload(rk1, rv1, Kt, Vt, 1);
  __syncthreads();
  for (int kt = 0; kt < nt; kt += 2) {
    attnA_compute(sm, sm + 64 * AK_LD, bq, O, ls, m2, r, hh);
    attnA_sstore(rk1, rv1, sKt + A_STAGE, sVt + A_STAGE);
    attnA_gload(rk0, rv0, Kt, Vt, min(kt + 2, nt - 1));
    __syncthreads();
    attnA_compute(sm + A_STAGE, sm + A_STAGE + 64 * AK_LD, bq, O, ls, m2, r, hh);
    attnA_sstore(rk0, rv0, sKt, sVt);
    attnA_gload(rk1, rv1, Kt, Vt, min(kt + 3, nt - 1));
    __syncthreads();
  }
  float l0 = ls[0], l1 = ls[1];
  l0 += __shfl_xor(l0, 32);
  l1 += __shfl_xor(l1, 32);
  const float i0 = 1.0f / l0, i1 = lam / l1;
  float o[2][16];
  float ss = 0.f;
#pragma unroll
  for (int d = 0; d < 2; ++d)
#pragma unroll
    for (int k = 0; k < 16; ++k) { o[d][k] = O[0][d][k] * i0 - O[1][d][k] * i1; ss += o[d][k] * o[d][k]; }
  ss += __shfl_xor(ss, 32);
  const float rinv = rsqrtf(ss * (1.0f / 64) + EPS) * (1.0f - lam_init);
  const float* subln = p.in[18] + l * 64;
#pragma unroll
  for (int d = 0; d < 2; ++d)
#pragma unroll
    for (int g = 0; g < 4; ++g) {
      const int dv0 = d * 32 + 8 * g + 4 * hh;
      float vv[4];
#pragma unroll
      for (int e = 0; e < 4; ++e) vv[e] = o[d][4 * g + e] * rinv * subln[dv0 + e];
      st4bf(MIX + R * DM + h * 64 + dv0, vv);
    }
}

DI void attnB_item(const Params& p, int l, int b, int hq, int qb, bool ctxq) {
  const int t_ = opq(threadIdx.x);
  const int lane = t_ & 63, wave = t_ >> 6, r = lane & 31, hh = lane >> 5;
  const u16* QB = (const u16*)(p.ws + OFF_QB); const u16* KB = (const u16*)(p.ws + OFF_KB); const u16* VBT = (const u16*)(p.ws + OFF_VBT);
  u16* MIX = (u16*)(p.ws + OFF_H);
  const float* misc = (const float*)(p.ws + OFF_MISC);
  const float m2 = misc[l * 4 + 3];
  const int kvh = hq >> 1;
  const int tpos0 = qb * 128 + wave * 32;
  const int i = (ctxq ? 0 : NCTX) + tpos0 + r;
  const size_t R = (size_t)b * TB + i;
  bf16x8 bq[4];
#pragma unroll
  for (int ks = 0; ks < 4; ++ks) bq[ks] = *(const bf16x8*)(QB + R * 256 + hq * 64 + ks * 16 + hh * 8);
  f32x16 O[2];
#pragma unroll
  for (int d = 0; d < 2; ++d)
#pragma unroll
    for (int k = 0; k < 16; ++k) O[d][k] = 0.f;
  float ls = 0.f;
  const u16* Kc = KB + (size_t)b * TB * 128 + kvh * 64;
  const u16* Vc = VBT + ((size_t)b * 128 + kvh * 64) * TB;
  if (!ctxq) {
    int lo = tpos0 - 128; if (lo < 0) lo = 0;
    int hi = tpos0 + 32 + 128; if (hi > 8192) hi = 8192;
    attn_stream<64, true>(bq, Kc + (size_t)NCTX * 128, 128, Vc + NCTX, TB, lo / 32, hi / 32, tpos0 + r, m2, O, ls, lane);
  }
  attn_stream<64, false>(bq, Kc, 128, Vc, TB, 0, NCTX / 32, 0, m2, O, ls, lane);
  ls += __shfl_xor(ls, 32);
  ls += __builtin_amdgcn_exp2f(p.in[21][l * 4 + hq] * LOG2E - m2);
  const float inv = 1.0f / ls;
#pragma unroll
  for (int d = 0; d < 2; ++d)
#pragma unroll
    for (int g = 0; g < 4; ++g) {
      const int dv0 = d * 32 + 8 * g + 4 * hh;
      float vv[4];
#pragma unroll
      for (int e = 0; e < 4; ++e) vv[e] = O[d][4 * g + e] * inv;
      st4bf(MIX + R * DM + 256 + hq * 64 + dv0, vv);
    }
}

DI void ssd_cum(const Params& p, int l, int b, int mc, int dir, int h, float* s_dt, float* s_cum, int lane) {
  const float A = -expf(p.in[25][l * 16 + dir * 8 + h]);
  const float* DT = (const float*)(p.ws + OFF_DT);
  const size_t R0 = (size_t)b * TB + mc * 128;
  const float d0 = DT[(R0 + 2 * lane) * 16 + dir * 8 + h];
  const float d1 = DT[(R0 + 2 * lane + 1) * 16 + dir * 8 + h];
  const float a0 = d0 * A, a1 = d1 * A, ps = a0 + a1;
  float inc = ps;
#pragma unroll
  for (int off = 1; off < 64; off <<= 1) {
    float v = __shfl_up(inc, off);
    if (lane >= off) inc += v;
  }
  const float pre0 = inc - ps + a0, pre1 = inc;
  float c0 = pre0, c1 = pre1;
  if (dir == 1) {
    const float tot = __shfl(inc, 63);
    c0 = tot - pre0 + a0;
    c1 = tot - pre1 + a1;
  }
  s_dt[2 * lane] = d0; s_dt[2 * lane + 1] = d1;
  s_cum[2 * lane] = c0; s_cum[2 * lane + 1] = c1;
}
DI int proc_chunk(int mc, int dir) { return dir == 0 ? mc : (mc < 2 ? 1 - mc : 67 - mc); }

DI void stage_xsT(const Params& p, int b, int mc, int h, u16* sXT, int t) {
  const int ll = t & 127, half = t >> 7;
  const u16* XS = (const u16*)(p.ws + OFF_XS);
  const u16* src = XS + ((size_t)b * TB + mc * 128 + ll) * 512 + h * 64 + half * 32;
#pragma unroll
  for (int c = 0; c < 4; ++c) {
    uint4 u = *(const uint4*)(src + c * 8);
    const int p0 = half * 32 + c * 8;
    sXT[(p0 + 0) * 136 + ll] = (u16)(u.x & 0xffff); sXT[(p0 + 1) * 136 + ll] = (u16)(u.x >> 16);
    sXT[(p0 + 2) * 136 + ll] = (u16)(u.y & 0xffff); sXT[(p0 + 3) * 136 + ll] = (u16)(u.y >> 16);
    sXT[(p0 + 4) * 136 + ll] = (u16)(u.z & 0xffff); sXT[(p0 + 5) * 136 + ll] = (u16)(u.z >> 16);
    sXT[(p0 + 6) * 136 + ll] = (u16)(u.w & 0xffff); sXT[(p0 + 7) * 136 + ll] = (u16)(u.w >> 16);
  }
}

DI void ssd1_item(const Params& p, int l, int b, int mc, int h, char* smem) {
  u16* sXT = (u16*)smem;
  u16* sBT = sXT + 64 * 136;
  float* s_dt = (float*)(sBT + 2 * 64 * 136);
  float* s_cum = s_dt + 256;
  const int t = opq(threadIdx.x), lane = t & 63, wave = t >> 6, r = lane & 31, hh = lane >> 5;
  const int g = h >> 2;
  if (wave < 2) ssd_cum(p, l, b, mc, wave, h, s_dt + wave * 128, s_cum + wave * 128, lane);
  __syncthreads();
  stage_xsT(p, b, mc, h, sXT, t);
  {
    const int ll = t & 127, half = t >> 7;
    const u16* BM = (const u16*)(p.ws + OFF_BM);
    const u16* src = BM + ((size_t)b * TB + mc * 128 + ll) * 128 + g * 64 + half * 32;
    const float w0 = s_dt[ll] * fexp(s_cum[127] - s_cum[ll]);
    const float w1 = s_dt[128 + ll] * fexp(s_cum[128 + 0] - s_cum[128 + ll]);
#pragma unroll
    for (int c = 0; c < 4; ++c) {
      uint4 u = *(const uint4*)(src + c * 8);
      unsigned uu[4] = {u.x, u.y, u.z, u.w};
      const int n0 = half * 32 + c * 8;
#pragma unroll
      for (int e = 0; e < 4; ++e) {
        float lo = bflo(uu[e]), hi = bfhi(uu[e]);
        sBT[(n0 + 2 * e) * 136 + ll] = f2bf(lo * w0);
        sBT[(n0 + 2 * e + 1) * 136 + ll] = f2bf(hi * w0);
        sBT[64 * 136 + (n0 + 2 * e) * 136 + ll] = f2bf(lo * w1);
        sBT[64 * 136 + (n0 + 2 * e + 1) * 136 + ll] = f2bf(hi * w1);
      }
    }
  }
  __syncthreads();
  {
    const int dir = wave >> 1, pt = wave & 1;
    f32x16 acc[2];
#pragma unroll
    for (int n = 0; n < 2; ++n)
#pragma unroll
      for (int k = 0; k < 16; ++k) acc[n][k] = 0.f;
    const u16* bt = sBT + dir * 64 * 136;
#pragma unroll
    for (int ks = 0; ks < 8; ++ks) {
      bf16x8 af = *(const bf16x8*)(sXT + (pt * 32 + r) * 136 + ks * 16 + hh * 8);
#pragma unroll
      for (int nt = 0; nt < 2; ++nt) {
        bf16x8 bfr = *(const bf16x8*)(bt + (nt * 32 + r) * 136 + ks * 16 + hh * 8);
        acc[nt] = MFMA32(af, bfr, acc[nt]);
      }
    }
    const int pc = proc_chunk(mc, dir);
    float* ST = (float*)(p.ws + OFF_R1) + ((size_t)(((b * 2 + dir) * 8 + h) * 66 + pc)) * 4096;
#pragma unroll
    for (int nt = 0; nt < 2; ++nt)
#pragma unroll
      for (int k = 0; k < 16; ++k) ST[(pt * 32 + crow(k, hh)) * 64 + nt * 32 + r] = acc[nt][k];
    if (lane == 0 && pt == 0) ((float*)(p.ws + OFF_ATOT))[((b * 2 + dir) * 8 + h) * 66 + pc] = s_cum[dir * 128 + (dir == 0 ? 127 : 0)];
  }
  __syncthreads();
}

DI void ssd2_phase(const Params& p, int bid, int nb) {
  float* ST = (float*)(p.ws + OFF_R1);
  const float* AT = (const float*)(p.ws + OFF_ATOT);
  const int t_ = opq(threadIdx.x);
  for (int gid = bid * 256 + t_; gid < 32 * 4096; gid += nb * 256) {
    const int bdh = gid >> 12, e = gid & 4095;
    float* base = ST + (size_t)bdh * 66 * 4096 + e;
    const float* at = AT + bdh * 66;
    float prev = 0.f;
    for (int pc0 = 0; pc0 < 66; pc0 += 33) {
      float loc[33];
#pragma unroll
      for (int j = 0; j < 33; ++j) loc[j] = base[(size_t)(pc0 + j) * 4096];
#pragma unroll
      for (int j = 0; j < 33; ++j) {
        const float dec = fexp(at[pc0 + j]);
        base[(size_t)(pc0 + j) * 4096] = prev;
        prev = dec * prev + loc[j];
      }
    }
  }
}

DI void ssd3_item(const Params& p, int l, int b, int mc, int g, int th, char* smem) {
  u16* sB = (u16*)smem;
  u16* sXT = sB + 128 * 72;
  float* s_dt = (float*)(sXT + 2 * 64 * 136);
  float* s_cum = s_dt + 8 * 128;
  float* s_red = s_cum + 8 * 128;
  const int t = opq(threadIdx.x), lane = t & 63, wave = t >> 6, r = lane & 31, hh = lane >> 5;
  const int tsub = wave & 1, hpair = wave >> 1;
  const u16* BM = (const u16*)(p.ws + OFF_BM); const u16* CM = (const u16*)(p.ws + OFF_CM);
  const u16* Z = (const u16*)(p.ws + OFF_Z);
  u16* MIX = (u16*)(p.ws + OFF_H);
  __syncthreads();
#pragma unroll
  for (int q = 0; q < 2; ++q) {
    const int hd = wave * 2 + q;
    ssd_cum(p, l, b, mc, hd & 1, g * 4 + (hd >> 1), s_dt + hd * 128, s_cum + hd * 128, lane);
  }
  {
    const int row = t >> 1, half = t & 1;
    const u16* src = BM + ((size_t)b * TB + mc * 128 + row) * 128 + g * 64 + half * 32;
#pragma unroll
    for (int c = 0; c < 4; ++c) *(u32x4*)(sB + row * 72 + half * 32 + c * 8) = *(const u32x4*)(src + c * 8);
  }
  const int ltok = th * 64 + tsub * 32 + r;
  const size_t R = (size_t)b * TB + mc * 128 + ltok;
  bf16x8 cf[4];
#pragma unroll
  for (int ks = 0; ks < 4; ++ks) cf[ks] = *(const bf16x8*)(CM + R * 128 + g * 64 + ks * 16 + hh * 8);
  float ssq = 0.f;
#pragma unroll 1
  for (int hl2 = 0; hl2 < 2; ++hl2) {
    __syncthreads();
    stage_xsT(p, b, mc, g * 4 + hl2, sXT, t);
    stage_xsT(p, b, mc, g * 4 + 2 + hl2, sXT + 64 * 136, t);
    __syncthreads();
    const int hl = hpair * 2 + hl2, h = g * 4 + hl;
    const u16* myXT = sXT + hpair * 64 * 136;
    const float dskip = p.in[26][l * 8 + h];
    f32x16 Y[2];
#pragma unroll
    for (int pt = 0; pt < 2; ++pt)
#pragma unroll
      for (int k = 0; k < 16; ++k) Y[pt][k] = 0.f;
#pragma unroll 1
    for (int dir = 0; dir < 2; ++dir) {
      const float cl = s_cum[(hl * 2 + dir) * 128 + ltok];
      const int pc = proc_chunk(mc, dir);
      const float* Sp = (const float*)(p.ws + OFF_R1) + ((size_t)(((b * 2 + dir) * 8 + h) * 66 + pc)) * 4096;
      f32x16 yo[2];
#pragma unroll
      for (int pt = 0; pt < 2; ++pt)
#pragma unroll
        for (int k = 0; k < 16; ++k) yo[pt][k] = 0.f;
#pragma unroll
      for (int ks = 0; ks < 4; ++ks)
#pragma unroll
        for (int pt = 0; pt < 2; ++pt) {
          const float4* sp4 = (const float4*)(Sp + (pt * 32 + r) * 64 + ks * 16 + hh * 8);
          float4 x0 = sp4[0], x1 = sp4[1];
          float tmp[8] = {x0.x, x0.y, x0.z, x0.w, x1.x, x1.y, x1.z, x1.w};
          bf16x8 sf = pack8(tmp);
          yo[pt] = MFMA32(sf, cf[ks], yo[pt]);
        }
      const float ecl = fexp(cl);
#pragma unroll
      for (int pt = 0; pt < 2; ++pt)
#pragma unroll
        for (int k = 0; k < 16; ++k) Y[pt][k] += ecl * yo[pt][k];
    }
#pragma unroll 1
    for (int st = 0; st < 4; ++st) {
      f32x16 cbt;
#pragma unroll
      for (int k = 0; k < 16; ++k) cbt[k] = 0.f;
#pragma unroll
      for (int ks = 0; ks < 4; ++ks) {
        bf16x8 bfrag = *(const bf16x8*)(sB + (st * 32 + r) * 72 + ks * 16 + hh * 8);
        cbt = MFMA32(bfrag, cf[ks], cbt);
      }
#pragma unroll
      for (int dir = 0; dir < 2; ++dir) {
        const float* cumv = s_cum + (hl * 2 + dir) * 128;
        const float* dtv = s_dt + (hl * 2 + dir) * 128;
        const float cl = cumv[ltok];
        float m[16];
#pragma unroll
        for (int k = 0; k < 16; ++k) {
          const int s = st * 32 + crow(k, hh);
          const bool valid = (dir == 0) ? (s <= ltok) : (s >= ltok);
          float val = valid ? cbt[k] * fexp(cl - cumv[s]) * dtv[s] : 0.f;
          if (dir == 0 && s == ltok) val += dskip;
          m[k] = val;
        }
#pragma unroll
        for (int s2 = 0; s2 < 2; ++s2) {
          bf16x8 pf = pack8(m + 8 * s2);
#pragma unroll
          for (int pt = 0; pt < 2; ++pt) {
            const u16* xp = myXT + (pt * 32 + r) * 136 + st * 32 + 16 * s2 + 4 * hh;
            s16x4 lo = *(const s16x4*)xp;
            s16x4 hi = *(const s16x4*)(xp + 8);
            bf16x8 xf = __builtin_shufflevector(lo, hi, 0, 1, 2, 3, 4, 5, 6, 7);
            Y[pt] = MFMA32(xf, pf, Y[pt]);
          }
        }
      }
    }
#pragma unroll
    for (int pt = 0; pt < 2; ++pt)
#pragma unroll
      for (int gq = 0; gq < 4; ++gq) {
        const int ch0 = h * 64 + pt * 32 + 8 * gq + 4 * hh;
        float zv[4];
        ld4bf(Z + R * 512 + ch0, zv);
        float yv[4];
#pragma unroll
        for (int e = 0; e < 4; ++e) { yv[e] = Y[pt][4 * gq + e] * fsilu(zv[e]); ssq += yv[e] * yv[e]; }
        st4bf(MIX + R * DM + 512 + ch0, yv);
      }
  }
  ssq += __shfl_xor(ssq, 32);
  if (hh == 0) s_red[wave * 32 + r] = ssq;
  __syncthreads();
  ssq += s_red[(wave ^ 2) * 32 + r];
  const float rinv = rsqrtf(ssq * (1.0f / 256) + EPS);
  const float* gn = p.in[27] + l * 512;
  for (int hl2 = 0; hl2 < 2; ++hl2) {
    const int h = g * 4 + hpair * 2 + hl2;
#pragma unroll
    for (int pt = 0; pt < 2; ++pt)
#pragma unroll
      for (int gq = 0; gq < 4; ++gq) {
        const int ch0 = h * 64 + pt * 32 + 8 * gq + 4 * hh;
        float yv[4];
        ld4bf(MIX + R * DM + 512 + ch0, yv);
#pragma unroll
        for (int e = 0; e < 4; ++e) yv[e] = yv[e] * rinv * gn[ch0 + e];
        st4bf(MIX + R * DM + 512 + ch0, yv);
      }
  }
}

__global__ void __launch_bounds__(256, 2) fwd_megakernel(Params p) {
  __shared__ __attribute__((aligned(16))) char smem[73728];
  __shared__ uint4 xb_words;
  cg::grid_group grid = cg::this_grid();
  const int bid = blockIdx.x, nb = gridDim.x;
  unsigned* bar = (unsigned*)(p.ws + OFF_BAR);
  if (threadIdx.x == 0) xb_words = make_uint4(0u, 0u, 0u, 0u);
  __syncthreads();
  const XcdBarrier xb = xcd_barrier_post(bar, (volatile LAS unsigned*)&xb_words);
  if (p.ws == nullptr) grid.sync();

  for (int it = bid; it < CV_T5 + 576 + 1; it += nb) {
    if (it < CV_T5) convert_item(p, 0, it, smem);
    else if (it < CV_T5 + 576) mods_item(p, it - CV_T5, smem);
    else misc_item(p);
  }
  xcd_barrier(xb);

  for (int l = 0; l < 2; ++l) {
    const bool last = (l == 1);
    if (l == 1) {
      for (int it = bid; it < CV_T5; it += nb) convert_item(p, 1, it, smem);
    }
    normmod_phase(p, l, 0, bid, nb);
    xcd_barrier(xb);
    gemm_phase<0>(p, l, (const u16*)(p.ws + OFF_H), 1024, (const u16*)(p.ws + OFF_W13A), 44, 0.f, 0, smem, bid, nb);
    xcd_barrier(xb);
    gemm_phase<1>(p, l, (const u16*)(p.ws + OFF_R1), 2816, (const u16*)(p.ws + OFF_W2A), 8, 0.5f, 2, smem, bid, nb);
    xcd_barrier(xb);
    normmod_phase(p, l, 1, bid, nb);
    xcd_barrier(xb);
    gemm_phase<2>(p, l, (const u16*)(p.ws + OFF_H), 1024, (const u16*)(p.ws + OFF_WIN), 21, 0.f, 0, smem, bid, nb);
    xcd_barrier(xb);
    postproc_phase(p, l, bid, nb);
    xcd_barrier(xb);
    {
      const int nA = 512, nB = 512, nS = 1056, nAc = last ? 0 : 16, nBc = last ? 0 : 16;
      const int tot = nA + nB + nS + nAc + nBc;
      for (int it0 = bid; it0 < tot; it0 += nb) {
        int j = it0;
        if (j < nA + nB) j = (j & ~511) | ((j & 7) << 6) | ((j >> 3) & 63);
        if (j < nA) { attnA_item(p, l, j >> 8, (j >> 6) & 3, NCTX + (j & 63) * 128, TB, smem); continue; }
        j -= nA;
        if (j < nB) { attnB_item(p, l, j >> 8, (j >> 6) & 3, j & 63, false); continue; }
        j -= nB;
        if (j < nS) { ssd1_item(p, l, j / 528, (j % 528) >> 3, j & 7, smem); continue; }
        j -= nS;
        if (j < nAc) { attnA_item(p, l, j >> 3, (j >> 1) & 3, (j & 1) * 128, NCTX, smem); continue; }
        j -= nAc;
        attnB_item(p, l, j >> 3, (j >> 1) & 3, j & 1, true);
      }
    }
    xcd_barrier(xb);
    ssd2_phase(p, bid, nb);
    xcd_barrier(xb);
    {
      const int skip = last ? 8 : 0;
      for (int it = bid; it < 2 * (264 - skip); it += nb) {
        const int b = it / (264 - skip), rem = it % (264 - skip) + skip, mc = rem >> 2, g = (rem >> 1) & 1, th = rem & 1;
        ssd3_item(p, l, b, mc, g, th, smem);
      }
    }
    xcd_barrier(xb);
    gemm_phase<1>(p, l, (const u16*)(p.ws + OFF_H), 1024, (const u16*)(p.ws + OFF_WOUT), 8, 1.0f, 5, smem, bid, nb);
    xcd_barrier(xb);
    normmod_phase(p, l, 2, bid, nb);
    xcd_barrier(xb);
    gemm_phase<0>(p, l, (const u16*)(p.ws + OFF_H), 1024, (const u16*)(p.ws + OFF_W13B), 44, 0.f, 0, smem, bid, nb);
    xcd_barrier(xb);
    gemm_phase<1>(p, l, (const u16*)(p.ws + OFF_R1), 2816, (const u16*)(p.ws + OFF_W2B), 8, 0.5f, 8, smem, bid, nb);
    if (!last) xcd_barrier(xb);
  }
}

extern "C" void kernel_launch(void* const* d_in, const int* in_sizes, int n_in, void* d_out, int out_size,
                              void* d_ws, size_t ws_size, hipStream_t stream) {
  static int grid_blocks = 0;
  if (!grid_blocks) {
    int dev = 0, cus = 0, per_cu = 0;
    (void)hipGetDevice(&dev);
    (void)hipDeviceGetAttribute(&cus, hipDeviceAttributeMultiprocessorCount, dev);
    (void)hipOccupancyMaxActiveBlocksPerMultiprocessor(&per_cu, fwd_megakernel, 256, 0);
    if (per_cu > 2) per_cu = 2;
    if (per_cu < 1) per_cu = 1;
    grid_blocks = cus * per_cu;
  }
  if (ws_size < WS_TOTAL) { fprintf(stderr, "workspace too small: %zu < %zu\n", ws_size, (size_t)WS_TOTAL); return; }
  Params p{};
  for (int i = 0; i < 31; ++i) p.in[i] = (const float*)d_in[i];
  p.out = (float*)d_out;
  p.ws = (char*)d_ws;
  (void)hipMemsetAsync((char*)d_ws + OFF_BAR, 0, XCD_BAR_WORDS * sizeof(unsigned), stream);
  void* args[] = {&p};
  hipError_t e = hipLaunchCooperativeKernel((void*)fwd_megakernel, dim3(grid_blocks), dim3(256), args, 0, stream);
  if (e != hipSuccess) fprintf(stderr, "cooperative launch failed: %s (grid %d)\n", hipGetErrorString(e), grid_blocks);
}
```

```cpp
#include <hip/hip_runtime.h>
#include <hip/hip_cooperative_groups.h>
#include <cstdio>
namespace cg = cooperative_groups;

typedef __attribute__((ext_vector_type(8))) short bf16x8;
typedef __attribute__((ext_vector_type(4))) short s16x4;
typedef __attribute__((ext_vector_type(16))) float f32x16;
typedef __attribute__((ext_vector_type(2))) float f32x2;
typedef __attribute__((ext_vector_type(2))) __bf16 bf16x2_t;
typedef unsigned short u16;
typedef __attribute__((ext_vector_type(4))) unsigned u32x4;
#define DI __device__ __forceinline__
#define MFMA32(a, b, c) __builtin_amdgcn_mfma_f32_32x32x16_bf16((a), (b), (c), 0, 0, 0)

constexpr int TB = 8448, TR = 16896, DM = 1024, DFF = 2816, PST = 2560, NCTX = 256;
constexpr float LOG2E = 1.4426950408889634f;
constexpr float EPS = 1e-6f;

constexpr size_t al256(size_t x) { return (x + 255) & ~(size_t)255; }
constexpr size_t OFF_XC = 0;
constexpr size_t OFF_H = al256(OFF_XC + (size_t)512 * 1024 * 4);
constexpr size_t OFF_R1 = al256(OFF_H + (size_t)TR * 1024 * 2);
constexpr size_t OFF_DTRAW = al256(OFF_R1 + (size_t)TR * DFF * 2);
constexpr size_t OFF_QA = al256(OFF_DTRAW + (size_t)TR * 16 * 4);
constexpr size_t OFF_KA = al256(OFF_QA + (size_t)TR * 256 * 2);
constexpr size_t OFF_VAT = al256(OFF_KA + (size_t)TR * 256 * 2);
constexpr size_t OFF_QB = al256(OFF_VAT + (size_t)TR * 256 * 2);
constexpr size_t OFF_KB = al256(OFF_QB + (size_t)TR * 256 * 2);
constexpr size_t OFF_VBT = al256(OFF_KB + (size_t)TR * 128 * 2);
constexpr size_t OFF_Z = al256(OFF_VBT + (size_t)TR * 128 * 2);
constexpr size_t OFF_XS = al256(OFF_Z + (size_t)TR * 512 * 2);
constexpr size_t OFF_BM = al256(OFF_XS + (size_t)TR * 512 * 2);
constexpr size_t OFF_CM = al256(OFF_BM + (size_t)TR * 128 * 2);
constexpr size_t OFF_DT = al256(OFF_CM + (size_t)TR * 128 * 2);
constexpr size_t OFF_ATOT = al256(OFF_DT + (size_t)TR * 16 * 4);
constexpr size_t OFF_MODS = al256(OFF_ATOT + (size_t)32 * 66 * 4);
constexpr size_t OFF_MISC = al256(OFF_MODS + (size_t)2 * 3 * 9216 * 4);
constexpr size_t OFF_BAR = al256(OFF_MISC + 256);
constexpr size_t OFF_W13A = al256(OFF_BAR + 3456 * 4);
constexpr size_t OFF_W2A = al256(OFF_W13A + (size_t)5632 * 1024 * 2);
constexpr size_t OFF_WIN = al256(OFF_W2A + (size_t)1024 * 2816 * 2);
constexpr size_t OFF_WOUT = al256(OFF_WIN + (size_t)2688 * 1024 * 2);
constexpr size_t OFF_W13B = al256(OFF_WOUT + (size_t)1024 * 1024 * 2);
constexpr size_t OFF_W2B = al256(OFF_W13B + (size_t)5632 * 1024 * 2);
constexpr size_t WS_TOTAL = al256(OFF_W2B + (size_t)1024 * 2816 * 2);

struct Params {
  const float* in[31];
  float* out;
  char* ws;
};

DI unsigned pk2(float a, float b) { f32x2 v = {a, b}; return __builtin_bit_cast(unsigned, __builtin_convertvector(v, bf16x2_t)); }
DI u16 f2bf(float a) { return __builtin_bit_cast(u16, (__bf16)a); }
DI float bf2f(u16 h) { return __uint_as_float(((unsigned)h) << 16); }
DI float bflo(unsigned u) { return __uint_as_float(u << 16); }
DI float bfhi(unsigned u) { return __uint_as_float(u & 0xffff0000u); }
DI int opq(int x) { asm volatile("" : "+v"(x)); return x; }
DI int crow(int i, int hh) { return (i & 3) + 8 * (i >> 2) + 4 * hh; }
DI float fexp(float x) { return __builtin_amdgcn_exp2f(x * LOG2E); }
DI float fsilu(float x) { return x * __builtin_amdgcn_rcpf(1.0f + fexp(-x)); }
DI float wave_sum(float v) {
#pragma unroll
  for (int off = 32; off > 0; off >>= 1) v += __shfl_xor(v, off);
  return v;
}
DI bf16x8 pack8(const float* p) {
  uint4 u;
  u.x = pk2(p[0], p[1]); u.y = pk2(p[2], p[3]); u.z = pk2(p[4], p[5]); u.w = pk2(p[6], p[7]);
  return __builtin_bit_cast(bf16x8, u);
}
DI float* stream_row(const Params& p, int b, int i) {
  return (i < NCTX) ? (float*)(p.ws + OFF_XC) + (size_t)(b * NCTX + i) * DM : p.out + ((size_t)b * 8192 + (i - NCTX)) * DM;
}
DI const float* input_row(const Params& p, int b, int i) {
  return (i < NCTX) ? p.in[2] + (size_t)(b * NCTX + i) * DM : p.in[0] + ((size_t)b * 8192 + (i - NCTX)) * DM;
}


#define XB_TMO      128
#define XB_XCNT(j)  (256  + 64 * (j))
#define XB_XSUB(j)  (1280 + 64 * (j))
#define XB_XGEN(j)  (2304 + 64 * (j))
#define XB_TOP      3328
#define XB_TOPGEN   3392
#define XCD_BAR_WORDS 3456
#define XB_SPIN_CAP (1u << 18)
#define LAS __attribute__((address_space(3)))
DI unsigned xb_ld(unsigned* p)              { return __hip_atomic_load(p, __ATOMIC_RELAXED, __HIP_MEMORY_SCOPE_AGENT); }
DI unsigned xb_add(unsigned* p, unsigned v) { return __hip_atomic_fetch_add(p, v, __ATOMIC_RELAXED, __HIP_MEMORY_SCOPE_AGENT); }
DI unsigned xb_xcc_id() { return (unsigned)__builtin_amdgcn_s_getreg((3 << 11) | 20) & 0xFu; }
#define XB_SPIN(cond, bar) do { unsigned _sp = 0; while (cond) { __builtin_amdgcn_s_sleep(1); \
    if ((++_sp & 255u) == 0u) { if (xb_ld(&(bar)[XB_TMO])) break; if (_sp > XB_SPIN_CAP) { atomicAdd(&(bar)[XB_TMO], 1u); break; } } } } while (0)
struct XcdBarrier { unsigned* bar; unsigned x; volatile LAS unsigned* st; };
DI XcdBarrier xcd_barrier_post(unsigned* bar, volatile LAS unsigned* st) {
  XcdBarrier b; b.bar = bar; b.x = xb_xcc_id(); b.st = st;
  if (threadIdx.x == 0) (void)xb_add(&bar[XB_XCNT(b.x)], 1u);
  return b;
}
DI void xcd_barrier_complete(unsigned* bar, unsigned x, unsigned& nloc, unsigned& nx) {
  const unsigned G = gridDim.x * gridDim.y * gridDim.z;
  unsigned sum, cnt, mine, sp = 0u;
  for (;;) {
    sum = 0u; cnt = 0u; mine = 0u;
#pragma unroll
    for (unsigned j = 0; j < 16; ++j) { const unsigned c = xb_ld(&bar[XB_XCNT(j)]); sum += c; cnt += (c > 0u) ? 1u : 0u; mine = (j == x) ? c : mine; }
    if (sum == G) break;
    __builtin_amdgcn_s_sleep(1);
    if ((++sp & 255u) == 0u) { if (xb_ld(&bar[XB_TMO])) break; if (sp > XB_SPIN_CAP) { atomicAdd(&bar[XB_TMO], 1u); break; } }
  }
  nloc = mine > 0u ? mine : 1u; nx = cnt > 0u ? cnt : 1u;
}
DI void xcd_barrier(const XcdBarrier& b) {
  asm volatile("s_waitcnt vmcnt(0)" ::: "memory");
  __syncthreads();
  if (threadIdx.x == 0) {
    unsigned* bar = b.bar;
    __builtin_amdgcn_s_waitcnt(0);
    unsigned nloc = b.st[0], nx = b.st[1];
    if (nloc == 0u) { xcd_barrier_complete(bar, b.x, nloc, nx); b.st[0] = nloc; b.st[1] = nx; }
    const unsigned old = xb_add(&bar[XB_XSUB(b.x)], 1u);
    const unsigned gen = old / nloc;
    if (old + 1u == (gen + 1u) * nloc) {
      __builtin_amdgcn_fence(__ATOMIC_RELEASE, "agent");
      asm volatile("s_waitcnt vmcnt(0)" ::: "memory");
      const unsigned og = xb_add(&bar[XB_TOP], 1u);
      const unsigned tg = og / nx;
      if (og + 1u == (tg + 1u) * nx) xb_add(&bar[XB_TOPGEN], 1u);
      else XB_SPIN(xb_ld(&bar[XB_TOPGEN]) == tg, bar);
      __builtin_amdgcn_fence(__ATOMIC_ACQUIRE, "agent");
      xb_add(&bar[XB_XGEN(b.x)], 1u);
      asm volatile("s_waitcnt vmcnt(0)" ::: "memory");
    } else {
      XB_SPIN(xb_ld(&bar[XB_XGEN(b.x)]) == gen, bar);
      __builtin_amdgcn_fence(__ATOMIC_ACQUIRE, "agent");
      asm volatile("s_waitcnt vmcnt(0)" ::: "memory");
    }
  }
  __syncthreads();
}

DI void convert_tile(const float* __restrict__ src, u16* __restrict__ dst, int K, int N, int ntn, int idx, bool swiglu_perm, char* smem) {
  float* tile = (float*)smem;
  const int t = opq(threadIdx.x);
  const int kt = idx / ntn, nt = idx % ntn, k0 = kt * 64, n0 = nt * 64;
  {
    const int col = t & 63, r0 = t >> 6;
    const int n = n0 + col;
    float vv[16];
#pragma unroll
    for (int q = 0; q < 16; ++q) vv[q] = (n < N) ? __builtin_nontemporal_load(&src[(size_t)(k0 + r0 + 4 * q) * N + n]) : 0.0f;
#pragma unroll
    for (int q = 0; q < 16; ++q) tile[col * 65 + r0 + 4 * q] = vv[q];
  }
  __syncthreads();
  {
    const int kp = t & 31, nn0 = t >> 5;
#pragma unroll
    for (int j = 0; j < 8; ++j) {
      const int nn = nn0 + 8 * j, n = n0 + nn;
      int np = n;
      if (swiglu_perm) {
        if (n < DFF) np = (n >> 5) * 64 + (n & 31);
        else { int jj = n - DFF; np = (jj >> 5) * 64 + 32 + (jj & 31); }
      }
      unsigned v = pk2(tile[nn * 65 + 2 * kp], tile[nn * 65 + 2 * kp + 1]);
      *(unsigned*)(dst + (size_t)np * K + k0 + 2 * kp) = v;
    }
  }
  __syncthreads();
}

constexpr int CV_T0 = 1408, CV_T1 = CV_T0 + 704, CV_T2 = CV_T1 + 672, CV_T3 = CV_T2 + 256, CV_T4 = CV_T3 + 1408, CV_T5 = CV_T4 + 704;

DI void convert_item(const Params& p, int l, int idx, char* smem) {
  if (idx < CV_T0) convert_tile(p.in[7] + (size_t)l * 1024 * 5632, (u16*)(p.ws + OFF_W13A), 1024, 5632, 88, idx, true, smem);
  else if (idx < CV_T1) convert_tile(p.in[8] + (size_t)l * 2816 * 1024, (u16*)(p.ws + OFF_W2A), 2816, 1024, 16, idx - CV_T0, false, smem);
  else if (idx < CV_T2) convert_tile(p.in[10] + (size_t)l * 1024 * 2576, (u16*)(p.ws + OFF_WIN), 1024, 2576, 42, idx - CV_T1, false, smem);
  else if (idx < CV_T3) convert_tile(p.in[11] + (size_t)l * 1024 * 1024, (u16*)(p.ws + OFF_WOUT), 1024, 1024, 16, idx - CV_T2, false, smem);
  else if (idx < CV_T4) convert_tile(p.in[29] + (size_t)l * 1024 * 5632, (u16*)(p.ws + OFF_W13B), 1024, 5632, 88, idx - CV_T3, true, smem);
  else convert_tile(p.in[30] + (size_t)l * 2816 * 1024, (u16*)(p.ws + OFF_W2B), 2816, 1024, 16, idx - CV_T4, false, smem);
}

DI void mods_item(const Params& p, int idx, char* smem) {
  float* sv = (float*)smem;
  float* red = sv + 3072;
  const int t = opq(threadIdx.x);
  const int l = idx / 576, n0 = (idx % 576) * 16;
  for (int e = t; e < 3072; e += 256) {
    int v = e >> 10, k = e & 1023;
    float xv = (v < 2) ? p.in[1][v * 1024 + k] : p.in[3][k];
    sv[e] = fsilu(xv);
  }
  __syncthreads();
  const int c = t & 15, kg = t >> 4;
  const float* w = p.in[4] + (size_t)l * 1024 * 9216 + n0 + c;
  float a0 = 0.f, a1 = 0.f, a2 = 0.f;
#pragma unroll 32
  for (int k = kg * 64; k < kg * 64 + 64; ++k) {
    float wv = __builtin_nontemporal_load(&w[(size_t)k * 9216]);
    a0 += sv[k] * wv; a1 += sv[1024 + k] * wv; a2 += sv[2048 + k] * wv;
  }
  red[(kg * 3 + 0) * 16 + c] = a0; red[(kg * 3 + 1) * 16 + c] = a1; red[(kg * 3 + 2) * 16 + c] = a2;
  __syncthreads();
  if (t < 48) {
    int v = t >> 4, cc = t & 15;
    float s = p.in[5][l * 9216 + n0 + cc];
#pragma unroll
    for (int g = 0; g < 16; ++g) s += red[(g * 3 + v) * 16 + cc];
    ((float*)(p.ws + OFF_MODS))[(l * 3 + v) * 9216 + n0 + cc] = s;
  }
  __syncthreads();
}

DI void misc_item(const Params& p) {
  const int t_ = opq(threadIdx.x);
  if (t_ < 2) {
    const int l = t_;
    float s1 = 0.f, s2 = 0.f, mqa = 0.f, mka = 0.f;
    for (int i = 0; i < 32; ++i) {
      s1 += p.in[14][l * 32 + i] * p.in[15][l * 32 + i];
      s2 += p.in[16][l * 32 + i] * p.in[17][l * 32 + i];
      mqa = fmaxf(mqa, fabsf(p.in[12][l * 32 + i]));
      mka = fmaxf(mka, fabsf(p.in[13][l * 32 + i]));
    }
    float mqb = 0.f, mkb = 0.f;
    for (int i = 0; i < 64; ++i) {
      mqb = fmaxf(mqb, fabsf(p.in[19][l * 64 + i]));
      mkb = fmaxf(mkb, fabsf(p.in[20][l * 64 + i]));
    }
    float lam_init = 0.8f - 0.6f * expf(-0.3f * (float)l);
    float* m = (float*)(p.ws + OFF_MISC);
    m[l * 4 + 0] = expf(s1) - expf(s2) + lam_init;
    m[l * 4 + 1] = lam_init;
    m[l * 4 + 2] = 32.0f * mqa * mka * 0.17677669529663687f * LOG2E * 1.01f;
    m[l * 4 + 3] = 64.0f * mqb * mkb * 0.125f * LOG2E * 1.01f;
  }
}

DI void normmod_phase(const Params& p, int l, int which, int bid, int nb) {
  const float* nw = p.in[which == 0 ? 6 : (which == 1 ? 9 : 28)] + l * DM;
  const int t_ = opq(threadIdx.x);
  const int wave = t_ >> 6, lane = t_ & 63;
  u16* H = (u16*)(p.ws + OFF_H);
  const bool from_input = (l == 0 && which == 0);
  for (int R = bid * 4 + wave; R < TR; R += nb * 4) {
    const int b = R / TB, i = R % TB;
    const bool isctx = i < NCTX;
    const float* src = from_input ? input_row(p, b, i) : stream_row(p, b, i);
    const float* mod = (const float*)(p.ws + OFF_MODS) + (size_t)(l * 3 + (isctx ? 2 : b)) * 9216;
    const float* shift = mod + (which * 3) * DM;
    const float* scale = mod + (which * 3 + 1) * DM;
    float4 v[4];
    float ss = 0.f;
#pragma unroll
    for (int j = 0; j < 4; ++j) {
      v[j] = ((const float4*)src)[lane + 64 * j];
      ss += v[j].x * v[j].x + v[j].y * v[j].y + v[j].z * v[j].z + v[j].w * v[j].w;
    }
    ss = wave_sum(ss);
    const float rinv = rsqrtf(ss * (1.0f / DM) + EPS);
    if (from_input) {
      float* dstrow = stream_row(p, b, i);
#pragma unroll
      for (int j = 0; j < 4; ++j) ((float4*)dstrow)[lane + 64 * j] = v[j];
    }
#pragma unroll
    for (int j = 0; j < 4; ++j) {
      const int c4 = lane + 64 * j;
      float4 w4 = ((const float4*)nw)[c4], sh = ((const float4*)shift)[c4], sc = ((const float4*)scale)[c4];
      float y0 = v[j].x * rinv * w4.x * (1.0f + sc.x) + sh.x;
      float y1 = v[j].y * rinv * w4.y * (1.0f + sc.y) + sh.y;
      float y2 = v[j].z * rinv * w4.z * (1.0f + sc.z) + sh.z;
      float y3 = v[j].w * rinv * w4.w * (1.0f + sc.w) + sh.w;
      uint2 o; o.x = pk2(y0, y1); o.y = pk2(y2, y3);
      *(uint2*)(H + (size_t)R * DM + c4 * 4) = o;
    }
  }
}

constexpr int G_LD = 40, G_STAGE = 384 * G_LD;
DI void gemm_gload(u32x4 (&ra)[4], u32x4 (&rb)[2], const u16* __restrict__ Agt, const u16* __restrict__ Bgt, int K, int kt) {
#pragma unroll
  for (int j = 0; j < 4; ++j) ra[j] = *(const u32x4*)(Agt + (size_t)(64 * j) * K + kt * 32);
#pragma unroll
  for (int j = 0; j < 2; ++j) rb[j] = *(const u32x4*)(Bgt + (size_t)(64 * j) * K + kt * 32);
}
DI void gemm_sstore(const u32x4 (&ra)[4], const u32x4 (&rb)[2], u16* sAt, u16* sBt) {
#pragma unroll
  for (int j = 0; j < 4; ++j) *(u32x4*)(sAt + 64 * j * G_LD) = ra[j];
#pragma unroll
  for (int j = 0; j < 2; ++j) *(u32x4*)(sBt + 64 * j * G_LD) = rb[j];
}
template <bool SWAP>
DI void gemm_compute(f32x16 (&acc)[4][2], const u16* a_, const u16* b_, int wm, int wn, int r, int hh) {
#pragma unroll
  for (int kk = 0; kk < 2; ++kk) {
    bf16x8 af[4], bfr[2];
#pragma unroll
    for (int mi = 0; mi < 4; ++mi) af[mi] = *(const bf16x8*)(a_ + (wm * 128 + mi * 32 + r) * G_LD + kk * 16 + hh * 8);
#pragma unroll
    for (int ni = 0; ni < 2; ++ni) bfr[ni] = *(const bf16x8*)(b_ + (wn * 64 + ni * 32 + r) * G_LD + kk * 16 + hh * 8);
#pragma unroll
    for (int mi = 0; mi < 4; ++mi)
#pragma unroll
      for (int ni = 0; ni < 2; ++ni) acc[mi][ni] = SWAP ? MFMA32(bfr[ni], af[mi], acc[mi][ni]) : MFMA32(af[mi], bfr[ni], acc[mi][ni]);
  }
  __builtin_amdgcn_iglp_opt(0);
}
template <bool SWAP>
DI void gemm_tile_kloop(f32x16 (&acc)[4][2], const u16* __restrict__ A, const u16* __restrict__ Bt, int K, int mt, int nt, int k0, int k1,
                        char* smem, int t, int wm, int wn, int r, int hh) {
#pragma unroll
  for (int a = 0; a < 4; ++a)
#pragma unroll
    for (int c = 0; c < 2; ++c)
#pragma unroll
      for (int i = 0; i < 16; ++i) acc[a][c][i] = 0.f;
  u16* sm = (u16*)smem;
  const int lrow = t >> 2, lkc = (t & 3) * 8;
  const u16* Agt = A + (size_t)(mt * 256 + lrow) * K + lkc;
  const u16* Bgt = Bt + (size_t)(nt * 128 + lrow) * K + lkc;
  u16* sAt = sm + lrow * G_LD + lkc;
  u16* sBt = sm + 256 * G_LD + lrow * G_LD + lkc;
  u32x4 ra0[4], rb0[2], ra1[4], rb1[2];
  gemm_gload(ra0, rb0, Agt, Bgt, K, k0);
  gemm_sstore(ra0, rb0, sAt, sBt);
  gemm_gload(ra1, rb1, Agt, Bgt, K, k0 + 1);
  __syncthreads();
  for (int kt = k0; kt < k1; kt += 2) {
    gemm_compute<SWAP>(acc, sm, sm + 256 * G_LD, wm, wn, r, hh);
    gemm_sstore(ra1, rb1, sAt + G_STAGE, sBt + G_STAGE);
    gemm_gload(ra0, rb0, Agt, Bgt, K, min(kt + 2, k1 - 1));
    __syncthreads();
    gemm_compute<SWAP>(acc, sm + G_STAGE, sm + G_STAGE + 256 * G_LD, wm, wn, r, hh);
    gemm_sstore(ra0, rb0, sAt, sBt);
    gemm_gload(ra1, rb1, Agt, Bgt, K, min(kt + 3, k1 - 1));
    __syncthreads();
  }
}

DI void st4bf_(u16* ptr, float a, float b, float c, float d) { uint2 u; u.x = pk2(a, b); u.y = pk2(c, d); *(uint2*)ptr = u; }
DI void epi_win(const Params& p, int l, f32x16 (&acc)[4][2], int mt, int nt, int wm, int wn, int r_, int hh_) {
  const int r = opq(r_), hh = opq(hh_);
  const int b = (mt * 256) / TB, i0 = (mt * 256) % TB;
  const bool isctx = i0 < NCTX;
#pragma unroll
  for (int mi = 0; mi < 4; ++mi) {
    const int itok = i0 + wm * 128 + mi * 32 + r;
    const size_t R = (size_t)b * TB + itok;
    const int tpos = itok - NCTX;
    const float rowp = (float)(tpos >> 6), colp = (float)(tpos & 63);
    if (nt < 4) {
      const bool isq = nt < 2;
      const float* w = p.in[isq ? 12 : 13] + l * 32;
      u16* dst = (u16*)(p.ws + (isq ? OFF_QA : OFF_KA)) + R * 256 + (nt & 1) * 128 + wn * 64;
      const float osc = isq ? 0.17677669529663687f * LOG2E : 1.0f;
#pragma unroll
      for (int ni = 0; ni < 2; ++ni) {
        f32x16& v = acc[mi][ni];
        float ss = 0.f;
#pragma unroll
        for (int i = 0; i < 16; ++i) ss += v[i] * v[i];
        ss += __shfl_xor(ss, 32);
        const float rinv = rsqrtf(ss * (1.0f / 32) + EPS);
#pragma unroll
        for (int i = 0; i < 16; ++i) v[i] *= rinv * w[crow(i, hh)];
        if (!isctx) {
#pragma unroll
          for (int g2 = 0; g2 < 2; ++g2)
#pragma unroll
            for (int e = 0; e < 4; ++e) {
              const int i = 8 * g2 + e;
              const float idx = (float)(e + 4 * hh);
              const float ang = (g2 == 0 ? rowp : colp) * __builtin_amdgcn_exp2f(-idx * (13.287712379549449f / 8));
              const float c = __cosf(ang), s = __sinf(ang);
              const float a = v[i], bb = v[i + 4];
              v[i] = a * c - bb * s;
              v[i + 4] = bb * c + a * s;
            }
        }
#pragma unroll
        for (int g = 0; g < 4; ++g) st4bf_(dst + ni * 32 + 8 * g + 4 * hh, v[4 * g] * osc, v[4 * g + 1] * osc, v[4 * g + 2] * osc, v[4 * g + 3] * osc);
      }
    } else if (nt < 6) {
      u16* VAT = (u16*)(p.ws + OFF_VAT);
#pragma unroll
      for (int ni = 0; ni < 2; ++ni)
#pragma unroll
        for (int i = 0; i < 16; ++i) {
          const int ch = (nt - 4) * 128 + wn * 64 + ni * 32 + crow(i, hh);
          VAT[((size_t)b * 256 + ch) * TB + itok] = f2bf(acc[mi][ni][i]);
        }
    } else if (nt < 9) {
      const bool isq = nt < 8;
      const float* w = p.in[isq ? 19 : 20] + l * 64;
      u16* dst = isq ? (u16*)(p.ws + OFF_QB) + R * 256 + ((nt - 6) * 2 + wn) * 64 : (u16*)(p.ws + OFF_KB) + R * 128 + wn * 64;
      const float osc = isq ? 0.125f * LOG2E : 1.0f;
      f32x16 (&v)[2] = acc[mi];
      float ss = 0.f;
#pragma unroll
      for (int ni = 0; ni < 2; ++ni)
#pragma unroll
        for (int i = 0; i < 16; ++i) ss += v[ni][i] * v[ni][i];
      ss += __shfl_xor(ss, 32);
      const float rinv = rsqrtf(ss * (1.0f / 64) + EPS);
#pragma unroll
      for (int ni = 0; ni < 2; ++ni)
#pragma unroll
        for (int i = 0; i < 16; ++i) v[ni][i] *= rinv * w[ni * 32 + crow(i, hh)];
      if (!isctx) {
#pragma unroll
        for (int ni = 0; ni < 2; ++ni)
#pragma unroll
          for (int i = 0; i < 8; ++i) {
            const float idx = (float)crow(i, hh);
            const float ang = (ni == 0 ? rowp : colp) * __builtin_amdgcn_exp2f(-idx * (13.287712379549449f / 16));
            const float c = __cosf(ang), s = __sinf(ang);
            const float a = v[ni][i], bb = v[ni][i + 8];
            v[ni][i] = a * c - bb * s;
            v[ni][i + 8] = bb * c + a * s;
          }
      }
#pragma unroll
      for (int ni = 0; ni < 2; ++ni)
#pragma unroll
        for (int g = 0; g < 4; ++g)
          st4bf_(dst + ni * 32 + 8 * g + 4 * hh, v[ni][4 * g] * osc, v[ni][4 * g + 1] * osc, v[ni][4 * g + 2] * osc, v[ni][4 * g + 3] * osc);
    } else if (nt == 9) {
      u16* VBT = (u16*)(p.ws + OFF_VBT);
#pragma unroll
      for (int ni = 0; ni < 2; ++ni)
#pragma unroll
        for (int i = 0; i < 16; ++i) {
          const int ch = wn * 64 + ni * 32 + crow(i, hh);
          VBT[((size_t)b * 128 + ch) * TB + itok] = f2bf(acc[mi][ni][i]);
        }
    } else if (nt < 20) {
      u16* dst = (nt < 14) ? (u16*)(p.ws + OFF_Z) + R * 512 + (nt - 10) * 128 + wn * 64
                           : (u16*)(p.ws + OFF_R1) + R * 768 + (nt - 14) * 128 + wn * 64;
#pragma unroll
      for (int ni = 0; ni < 2; ++ni)
#pragma unroll
        for (int g = 0; g < 4; ++g)
          st4bf_(dst + ni * 32 + 8 * g + 4 * hh, acc[mi][ni][4 * g], acc[mi][ni][4 * g + 1], acc[mi][ni][4 * g + 2], acc[mi][ni][4 * g + 3]);
    } else {
      if (wn == 0) {
        float* DT = (float*)(p.ws + OFF_DT);
#pragma unroll
        for (int i = 0; i < 8; ++i) {
          const int c = crow(i, hh);
          const float x = acc[mi][0][i] + p.in[24][l * 16 + c];
          const float y = fexp(x);
          DT[R * 16 + c] = (x > 15.f) ? x : ((y < 1e-3f) ? (y - 0.5f * y * y) : logf(1.0f + y));
        }
      }
    }
    __builtin_amdgcn_sched_barrier(0);
  }
}

template <int EPI>
DI void gemm_phase(const Params& p, int l, const u16* __restrict__ A, int K, const u16* __restrict__ Bt, int ntn,
                   float coef, int gate_chunk, char* smem, int bid, int nb) {
  const int t = opq(threadIdx.x), lane = t & 63, wave = t >> 6, wm = wave >> 1, wn = wave & 1, r = lane & 31, hh = lane >> 5;
  const int ntiles = 66 * ntn;
  const int nk = K / 32;
  const int xcd = bid & 7, jloc = bid >> 3, chunk = nb >> 3;
  f32x16 acc[4][2];
  if (EPI == 1) {
    const int nk2 = nk >> 1;
    const long U = (long)ntiles * nk2;
    const int ord = xcd * chunk + jloc;
    long u = U * ord / nb;
    const long u_end = U * (ord + 1) / nb;
    while (u < u_end) {
      const int tile = (int)(u / nk2), kk0 = (int)(u % nk2);
      const int cnt = (int)min((long)(nk2 - kk0), u_end - u);
      const int mt = tile / ntn, nt = tile % ntn;
      gemm_tile_kloop<false>(acc, A, Bt, K, mt, nt, kk0 * 2, (kk0 + cnt) * 2, smem, t, wm, wn, r, hh);
      const int b = (mt * 256) / TB, i0 = (mt * 256) % TB;
      const bool isctx = i0 < NCTX;
      const float* gate = (const float*)(p.ws + OFF_MODS) + (size_t)(l * 3 + (isctx ? 2 : b)) * 9216 + gate_chunk * DM;
      float* tbase = stream_row(p, b, i0);
      const int re = opq(r), he = opq(hh);
#pragma unroll
      for (int ni = 0; ni < 2; ++ni) {
        const int col = nt * 128 + wn * 64 + ni * 32 + re;
        const float gc = coef * gate[col];
        const unsigned voff = (unsigned)((wm * 128 + 4 * he) * DM + col);
#pragma unroll
        for (int mi = 0; mi < 4; ++mi)
#pragma unroll
          for (int i = 0; i < 16; ++i)
            unsafeAtomicAdd(tbase + (voff + (unsigned)((mi * 32 + (i & 3) + 8 * (i >> 2)) * DM)), gc * acc[mi][ni][i]);
      }
      u += cnt;
    }
    return;
  }
  for (int cidx = xcd; cidx * chunk < ntiles; cidx += 8) {
    const int o = cidx * chunk + jloc;
    if (o >= ntiles) break;
    int mt, nt;
    if (o < 64 * ntn) { const int grp = o / (8 * ntn), within = o % (8 * ntn); nt = within >> 3; mt = grp * 8 + (within & 7); }
    else { const int within = o - 64 * ntn; nt = within >> 1; mt = 64 + (within & 1); }
    gemm_tile_kloop<EPI == 2>(acc, A, Bt, K, mt, nt, 0, nk, smem, t, wm, wn, r, hh);
    const int row_base = mt * 256 + wm * 128;
    if (EPI == 0) {
      u16* tbase = (u16*)(p.ws + OFF_R1) + (size_t)(mt * 256) * DFF;
      const int re = opq(r), he = opq(hh);
      const unsigned voff = (unsigned)((wm * 128 + 4 * he) * DFF + (nt * 128 + wn * 64) / 2 + re);
#pragma unroll
      for (int mi = 0; mi < 4; ++mi)
#pragma unroll
        for (int i = 0; i < 16; ++i) {
          const float g = acc[mi][0][i], u = acc[mi][1][i];
          tbase[voff + (unsigned)((mi * 32 + (i & 3) + 8 * (i >> 2)) * DFF)] = f2bf(fsilu(g) * u);
        }
    } else {
      epi_win(p, l, acc, mt, nt, wm, wn, r, hh);
    }
  }
}

DI void cv4bf(uint2 u, float (&v)[4]) { v[0] = bflo(u.x); v[1] = bfhi(u.x); v[2] = bflo(u.y); v[3] = bfhi(u.y); }
DI void ld4bf(const u16* ptr, float (&v)[4]) { cv4bf(*(const uint2*)ptr, v); }
DI void st4bf(u16* ptr, const float (&v)[4]) {
  uint2 u; u.x = pk2(v[0], v[1]); u.y = pk2(v[2], v[3]);
  *(uint2*)ptr = u;
}
DI void postproc_phase(const Params& p, int l, int bid, int nb) {
  const int t_ = opq(threadIdx.x);
  const int wave = t_ >> 6, lane = t_ & 63;
  const u16* XR = (const u16*)(p.ws + OFF_R1);
  u16* XS = (u16*)(p.ws + OFF_XS); u16* BM = (u16*)(p.ws + OFF_BM); u16* CM = (u16*)(p.ws + OFF_CM);
  const float* conv_w = p.in[22] + (size_t)l * 5 * 768; const float* conv_b = p.in[23] + l * 768;
  float4 cw[3][5], cb[3];
#pragma unroll
  for (int pass = 0; pass < 3; ++pass) {
    cb[pass] = *(const float4*)(conv_b + pass * 256 + lane * 4);
#pragma unroll
    for (int j = 0; j < 5; ++j) cw[pass][j] = *(const float4*)(conv_w + j * 768 + pass * 256 + lane * 4);
  }
  for (int R = bid * 4 + wave; R < TR; R += nb * 4) {
    const int b = R / TB, i = R % TB;
    const bool isctx = i < NCTX;
    uint2 ucv[3][5];
#pragma unroll
    for (int j = 0; j < 5; ++j) {
      const int ii = i + j - 2;
      const bool valid = isctx ? (ii >= 0 && ii < NCTX) : (ii >= NCTX && ii < TB);
      const u16* src = XR + (size_t)(b * TB + (valid ? ii : i)) * 768 + lane * 4;
#pragma unroll
      for (int pass = 0; pass < 3; ++pass) {
        uint2 u = *(const uint2*)(src + pass * 256);
        if (!valid) { u.x = 0u; u.y = 0u; }
        ucv[pass][j] = u;
      }
    }
#pragma unroll
    for (int pass = 0; pass < 3; ++pass) {
      float acc[4] = {cb[pass].x, cb[pass].y, cb[pass].z, cb[pass].w};
#pragma unroll
      for (int j = 0; j < 5; ++j) {
        float xv[4];
        cv4bf(ucv[pass][j], xv);
        acc[0] += xv[0] * cw[pass][j].x; acc[1] += xv[1] * cw[pass][j].y; acc[2] += xv[2] * cw[pass][j].z; acc[3] += xv[3] * cw[pass][j].w;
      }
#pragma unroll
      for (int e = 0; e < 4; ++e) acc[e] = fsilu(acc[e]);
      if (pass < 2) st4bf(XS + (size_t)R * 512 + pass * 256 + lane * 4, acc);
      else if (lane < 32) st4bf(BM + (size_t)R * 128 + lane * 4, acc);
      else st4bf(CM + (size_t)R * 128 + (lane - 32) * 4, acc);
    }
  }
}

template <int DQK, bool MASK>
DI void attn_stream(const bf16x8* bq, const u16* __restrict__ Kp, int ldk, const u16* __restrict__ VTp, int ldvt, int kt0, int kt1,
                    int qpos, float m2, f32x16* O, float& lsum, int lane) {
  const int r = lane & 31, hh = lane >> 5;
#pragma unroll 2
  for (int kt = kt0; kt < kt1; ++kt) {
    f32x16 s;
#pragma unroll
    for (int i = 0; i < 16; ++i) s[i] = 0.f;
#pragma unroll
    for (int ks = 0; ks < DQK / 16; ++ks) {
      bf16x8 ka = *(const bf16x8*)(Kp + (size_t)(kt * 32 + r) * ldk + ks * 16 + hh * 8);
      s = MFMA32(ka, bq[ks], s);
    }
    float pr[16];
#pragma unroll
    for (int i = 0; i < 16; ++i) {
      float x = s[i] - m2;
      float e = __builtin_amdgcn_exp2f(x);
      if (MASK) {
        const int kpos = kt * 32 + crow(i, hh);
        const int dd = kpos - qpos;
        if (dd > 128 || dd < -128) e = 0.f;
      }
      pr[i] = e;
      lsum += e;
    }
#pragma unroll
    for (int s2 = 0; s2 < 2; ++s2) {
      bf16x8 pf = pack8(pr + 8 * s2);
#pragma unroll
      for (int dt = 0; dt < 2; ++dt) {
        const u16* vp = VTp + (size_t)(dt * 32 + r) * ldvt + kt * 32 + 16 * s2 + 4 * hh;
        s16x4 lo = *(const s16x4*)vp;
        s16x4 hi = *(const s16x4*)(vp + 8);
        bf16x8 vf = __builtin_shufflevector(lo, hi, 0, 1, 2, 3, 4, 5, 6, 7);
        O[dt] = MFMA32(vf, pf, O[dt]);
      }
    }
  }
}

constexpr int AK_LD = 72, AV_LD = 68, A_STAGE = 64 * AK_LD + 64 * AV_LD;
DI void attnA_gload(u32x4 (&rk)[2], u32x4 (&rv)[2], const u16* __restrict__ Kt, const u16* __restrict__ Vt, int kt) {
#pragma unroll
  for (int j = 0; j < 2; ++j) {
    rk[j] = *(const u32x4*)(Kt + (size_t)(kt * 64 + 32 * j) * 256);
    rv[j] = *(const u32x4*)(Vt + (size_t)(32 * j) * TB + kt * 64);
  }
}
DI void attnA_sstore(const u32x4 (&rk)[2], const u32x4 (&rv)[2], u16* sKt, u16* sVt) {
#pragma unroll
  for (int j = 0; j < 2; ++j) {
    *(u32x4*)(sKt + 32 * j * AK_LD) = rk[j];
    uint2 lo, hi; lo.x = rv[j].x; lo.y = rv[j].y; hi.x = rv[j].z; hi.y = rv[j].w;
    *(uint2*)(sVt + 32 * j * AV_LD) = lo;
    *(uint2*)(sVt + 32 * j * AV_LD + 4) = hi;
  }
}
DI void attnA_compute(const u16* sK, const u16* sV, const bf16x8 (&bq)[2][2], f32x16 (&O)[2][2], float (&ls)[2], float m2, int r, int hh) {
  bf16x8 pf[2][2][2];
  float one = 1.0f;
  asm("" : "+v"(one));
#pragma unroll
  for (int sub = 0; sub < 2; ++sub)
#pragma unroll
    for (int c = 0; c < 2; ++c) {
      f32x16 s;
#pragma unroll
      for (int i = 0; i < 16; ++i) s[i] = -m2;
#pragma unroll
      for (int ks = 0; ks < 2; ++ks) {
        bf16x8 ka = *(const bf16x8*)(sK + (sub * 32 + r) * AK_LD + c * 32 + ks * 16 + hh * 8);
        s = MFMA32(ka, bq[c][ks], s);
      }
      float pr[16];
#pragma unroll
      for (int i = 0; i < 16; ++i) {
        pr[i] = __builtin_amdgcn_exp2f(s[i]);
        if (c == 0) ls[0] += pr[i]; else ls[1] = __builtin_fmaf(pr[i], one, ls[1]);
      }
      pf[c][sub][0] = pack8(pr);
      pf[c][sub][1] = pack8(pr + 8);
    }
#pragma unroll
  for (int sub = 0; sub < 2; ++sub)
#pragma unroll
    for (int s2 = 0; s2 < 2; ++s2)
#pragma unroll
      for (int dt = 0; dt < 2; ++dt) {
        const u16* vp = sV + (dt * 32 + r) * AV_LD + sub * 32 + 16 * s2 + 4 * hh;
        s16x4 lo = *(const s16x4*)vp;
        s16x4 hi = *(const s16x4*)(vp + 8);
        bf16x8 vf = __builtin_shufflevector(lo, hi, 0, 1, 2, 3, 4, 5, 6, 7);
#pragma unroll
        for (int c = 0; c < 2; ++c) O[c][dt] = MFMA32(vf, pf[c][sub][s2], O[c][dt]);
      }
}
DI void attnA_item(const Params& p, int l, int b, int h, int qrow0, int nkeys, char* smem) {
  const int t = opq(threadIdx.x);
  const int lane = t & 63, wave = t >> 6, r = lane & 31, hh = lane >> 5;
  const u16* QA = (const u16*)(p.ws + OFF_QA); const u16* KA = (const u16*)(p.ws + OFF_KA); const u16* VAT = (const u16*)(p.ws + OFF_VAT);
  u16* MIX = (u16*)(p.ws + OFF_H);
  const float* misc = (const float*)(p.ws + OFF_MISC);
  const float lam = misc[l * 4 + 0], lam_init = misc[l * 4 + 1], m2 = misc[l * 4 + 2];
  const int i = qrow0 + wave * 32 + r;
  const size_t R = (size_t)b * TB + i;
  bf16x8 bq[2][2];
#pragma unroll
  for (int c = 0; c < 2; ++c)
#pragma unroll
    for (int ks = 0; ks < 2; ++ks) bq[c][ks] = *(const bf16x8*)(QA + R * 256 + h * 64 + c * 32 + ks * 16 + hh * 8);
  f32x16 O[2][2];
#pragma unroll
  for (int c = 0; c < 2; ++c)
#pragma unroll
    for (int d = 0; d < 2; ++d)
#pragma unroll
      for (int k = 0; k < 16; ++k) O[c][d][k] = 0.f;
  float ls[2] = {0.f, 0.f};
  const int srow = t >> 3, sch = (t & 7) * 8;
  const u16* Kt = KA + ((size_t)b * TB + srow) * 256 + h * 64 + sch;
  const u16* Vt = VAT + ((size_t)b * 256 + h * 64 + srow) * TB + sch;
  u16* sm = (u16*)smem;
  u16* sKt = sm + srow * AK_LD + sch;
  u16* sVt = sm + 64 * AK_LD + srow * AV_LD + sch;
  const int nt = nkeys / 64;
  u32x4 rk0[2], rv0[2], rk1[2], rv1[2];
  __syncthreads();
  attnA_gload(rk0, rv0, Kt, Vt, 0);
  attnA_sstore(rk0, rv0, sKt, sVt);
  attnA_gload(rk1, rv1, Kt, Vt, 1);
  __syncthreads();
  for (int kt = 0; kt < nt; kt += 2) {
    attnA_compute(sm, sm + 64 * AK_LD, bq, O, ls, m2, r, hh);
    attnA_sstore(rk1, rv1, sKt + A_STAGE, sVt + A_STAGE);
    attnA_gload(rk0, rv0, Kt, Vt, min(kt + 2, nt - 1));
    __syncthreads();
    attnA_compute(sm + A_STAGE, sm + A_STAGE + 64 * AK_LD, bq, O, ls, m2, r, hh);
    attnA_sstore(rk0, rv0, sKt, sVt);
    attnA_gload(rk1, rv1, Kt, Vt, min(kt + 3, nt - 1));
    __syncthreads();
  }
  float l0 = ls[0], l1 = ls[1];
  l0 += __shfl_xor(l0, 32);
  l1 += __shfl_xor(l1, 32);
  const float i0 = 1.0f / l0, i1 = lam / l1;
  float o[2][16];
  float ss = 0.f;
#pragma unroll
  for (int d = 0; d < 2; ++d)
#pragma unroll
    for (int k = 0; k < 16; ++k) { o[d][k] = O[0][d][k] * i0 - O[1][d][k] * i1; ss += o[d][k] * o[d][k]; }
  ss += __shfl_xor(ss, 32);
  const float rinv = rsqrtf(ss * (1.0f / 64) + EPS) * (1.0f - lam_init);
  const float* subln = p.in[18] + l * 64;
#pragma unroll
  for (int d = 0; d < 2; ++d)
#pragma unroll
    for (int g = 0; g < 4; ++g) {
      const int dv0 = d * 32 + 8 * g + 4 * hh;
      float vv[4];
#pragma unroll
      for (int e = 0; e < 4; ++e) vv[e] = o[d][4 * g + e] * rinv * subln[dv0 + e];
      st4bf(MIX + R * DM + h * 64 + dv0, vv);
    }
}

DI void attnB_item(const Params& p, int l, int b, int hq, int qb, bool ctxq) {
  const int t_ = opq(threadIdx.x);
  const int lane = t_ & 63, wave = t_ >> 6, r = lane & 31, hh = lane >> 5;
  const u16* QB = (const u16*)(p.ws + OFF_QB); const u16* KB = (const u16*)(p.ws + OFF_KB); const u16* VBT = (const u16*)(p.ws + OFF_VBT);
  u16* MIX = (u16*)(p.ws + OFF_H);
  const float* misc = (const float*)(p.ws + OFF_MISC);
  const float m2 = misc[l * 4 + 3];
  const int kvh = hq >> 1;
  const int tpos0 = qb * 128 + wave * 32;
  const int i = (ctxq ? 0 : NCTX) + tpos0 + r;
  const size_t R = (size_t)b * TB + i;
  bf16x8 bq[4];
#pragma unroll
  for (int ks = 0; ks < 4; ++ks) bq[ks] = *(const bf16x8*)(QB + R * 256 + hq * 64 + ks * 16 + hh * 8);
  f32x16 O[2];
#pragma unroll
  for (int d = 0; d < 2; ++d)
#pragma unroll
    for (int k = 0; k < 16; ++k) O[d][k] = 0.f;
  float ls = 0.f;
  const u16* Kc = KB + (size_t)b * TB * 128 + kvh * 64;
  const u16* Vc = VBT + ((size_t)b * 128 + kvh * 64) * TB;
  if (!ctxq) {
    int lo = tpos0 - 128; if (lo < 0) lo = 0;
    int hi = tpos0 + 32 + 128; if (hi > 8192) hi = 8192;
    attn_stream<64, true>(bq, Kc + (size_t)NCTX * 128, 128, Vc + NCTX, TB, lo / 32, hi / 32, tpos0 + r, m2, O, ls, lane);
  }
  attn_stream<64, false>(bq, Kc, 128, Vc, TB, 0, NCTX / 32, 0, m2, O, ls, lane);
  ls += __shfl_xor(ls, 32);
  ls += __builtin_amdgcn_exp2f(p.in[21][l * 4 + hq] * LOG2E - m2);
  const float inv = 1.0f / ls;
#pragma unroll
  for (int d = 0; d < 2; ++d)
#pragma unroll
    for (int g = 0; g < 4; ++g) {
      const int dv0 = d * 32 + 8 * g + 4 * hh;
      float vv[4];
#pragma unroll
      for (int e = 0; e < 4; ++e) vv[e] = O[d][4 * g + e] * inv;
      st4bf(MIX + R * DM + 256 + hq * 64 + dv0, vv);
    }
}

DI void ssd_cum(const Params& p, int l, int b, int mc, int dir, int h, float* s_dt, float* s_cum, int lane) {
  const float A = -expf(p.in[25][l * 16 + dir * 8 + h]);
  const float* DT = (const float*)(p.ws + OFF_DT);
  const size_t R0 = (size_t)b * TB + mc * 128;
  const float d0 = DT[(R0 + 2 * lane) * 16 + dir * 8 + h];
  const float d1 = DT[(R0 + 2 * lane + 1) * 16 + dir * 8 + h];
  const float a0 = d0 * A, a1 = d1 * A, ps = a0 + a1;
  float inc = ps;
#pragma unroll
  for (int off = 1; off < 64; off <<= 1) {
    float v = __shfl_up(inc, off);
    if (lane >= off) inc += v;
  }
  const float pre0 = inc - ps + a0, pre1 = inc;
  float c0 = pre0, c1 = pre1;
  if (dir == 1) {
    const float tot = __shfl(inc, 63);
    c0 = tot - pre0 + a0;
    c1 = tot - pre1 + a1;
  }
  s_dt[2 * lane] = d0; s_dt[2 * lane + 1] = d1;
  s_cum[2 * lane] = c0; s_cum[2 * lane + 1] = c1;
}
DI int proc_chunk(int mc, int dir) { return dir == 0 ? mc : (mc < 2 ? 1 - mc : 67 - mc); }

DI void stage_xsT(const Params& p, int b, int mc, int h, u16* sXT, int t) {
  const int ll = t & 127, half = t >> 7;
  const u16* XS = (const u16*)(p.ws + OFF_XS);
  const u16* src = XS + ((size_t)b * TB + mc * 128 + ll) * 512 + h * 64 + half * 32;
#pragma unroll
  for (int c = 0; c < 4; ++c) {
    uint4 u = *(const uint4*)(src + c * 8);
    const int p0 = half * 32 + c * 8;
    sXT[(p0 + 0) * 136 + ll] = (u16)(u.x & 0xffff); sXT[(p0 + 1) * 136 + ll] = (u16)(u.x >> 16);
    sXT[(p0 + 2) * 136 + ll] = (u16)(u.y & 0xffff); sXT[(p0 + 3) * 136 + ll] = (u16)(u.y >> 16);
    sXT[(p0 + 4) * 136 + ll] = (u16)(u.z & 0xffff); sXT[(p0 + 5) * 136 + ll] = (u16)(u.z >> 16);
    sXT[(p0 + 6) * 136 + ll] = (u16)(u.w & 0xffff); sXT[(p0 + 7) * 136 + ll] = (u16)(u.w >> 16);
  }
}

DI void ssd1_item(const Params& p, int l, int b, int mc, int h, char* smem) {
  u16* sXT = (u16*)smem;
  u16* sBT = sXT + 64 * 136;
  float* s_dt = (float*)(sBT + 2 * 64 * 136);
  float* s_cum = s_dt + 256;
  const int t = opq(threadIdx.x), lane = t & 63, wave = t >> 6, r = lane & 31, hh = lane >> 5;
  const int g = h >> 2;
  if (wave < 2) ssd_cum(p, l, b, mc, wave, h, s_dt + wave * 128, s_cum + wave * 128, lane);
  __syncthreads();
  stage_xsT(p, b, mc, h, sXT, t);
  {
    const int ll = t & 127, half = t >> 7;
    const u16* BM = (const u16*)(p.ws + OFF_BM);
    const u16* src = BM + ((size_t)b * TB + mc * 128 + ll) * 128 + g * 64 + half * 32;
    const float w0 = s_dt[ll] * fexp(s_cum[127] - s_cum[ll]);
    const float w1 = s_dt[128 + ll] * fexp(s_cum[128 + 0] - s_cum[128 + ll]);
#pragma unroll
    for (int c = 0; c < 4; ++c) {
      uint4 u = *(const uint4*)(src + c * 8);
      unsigned uu[4] = {u.x, u.y, u.z, u.w};
      const int n0 = half * 32 + c * 8;
#pragma unroll
      for (int e = 0; e < 4; ++e) {
        float lo = bflo(uu[e]), hi = bfhi(uu[e]);
        sBT[(n0 + 2 * e) * 136 + ll] = f2bf(lo * w0);
        sBT[(n0 + 2 * e + 1) * 136 + ll] = f2bf(hi * w0);
        sBT[64 * 136 + (n0 + 2 * e) * 136 + ll] = f2bf(lo * w1);
        sBT[64 * 136 + (n0 + 2 * e + 1) * 136 + ll] = f2bf(hi * w1);
      }
    }
  }
  __syncthreads();
  {
    const int dir = wave >> 1, pt = wave & 1;
    f32x16 acc[2];
#pragma unroll
    for (int n = 0; n < 2; ++n)
#pragma unroll
      for (int k = 0; k < 16; ++k) acc[n][k] = 0.f;
    const u16* bt = sBT + dir * 64 * 136;
#pragma unroll
    for (int ks = 0; ks < 8; ++ks) {
      bf16x8 af = *(const bf16x8*)(sXT + (pt * 32 + r) * 136 + ks * 16 + hh * 8);
#pragma unroll
      for (int nt = 0; nt < 2; ++nt) {
        bf16x8 bfr = *(const bf16x8*)(bt + (nt * 32 + r) * 136 + ks * 16 + hh * 8);
        acc[nt] = MFMA32(af, bfr, acc[nt]);
      }
    }
    const int pc = proc_chunk(mc, dir);
    float* ST = (float*)(p.ws + OFF_R1) + ((size_t)(((b * 2 + dir) * 8 + h) * 66 + pc)) * 4096;
#pragma unroll
    for (int nt = 0; nt < 2; ++nt)
#pragma unroll
      for (int k = 0; k < 16; ++k) ST[(pt * 32 + crow(k, hh)) * 64 + nt * 32 + r] = acc[nt][k];
    if (lane == 0 && pt == 0) ((float*)(p.ws + OFF_ATOT))[((b * 2 + dir) * 8 + h) * 66 + pc] = s_cum[dir * 128 + (dir == 0 ? 127 : 0)];
  }
  __syncthreads();
}

DI void ssd2_phase(const Params& p, int bid, int nb) {
  float* ST = (float*)(p.ws + OFF_R1);
  const float* AT = (const float*)(p.ws + OFF_ATOT);
  const int t_ = opq(threadIdx.x);
  for (int gid = bid * 256 + t_; gid < 32 * 4096; gid += nb * 256) {
    const int bdh = gid >> 12, e = gid & 4095;
    float* base = ST + (size_t)bdh * 66 * 4096 + e;
    const float* at = AT + bdh * 66;
    float prev = 0.f;
    for (int pc0 = 0; pc0 < 66; pc0 += 33) {
      float loc[33];
#pragma unroll
      for (int j = 0; j < 33; ++j) loc[j] = base[(size_t)(pc0 + j) * 4096];
#pragma unroll
      for (int j = 0; j < 33; ++j) {
        const float dec = fexp(at[pc0 + j]);
        base[(size_t)(pc0 + j) * 4096] = prev;
        prev = dec * prev + loc[j];
      }
    }
  }
}

DI void ssd3_item(const Params& p, int l, int b, int mc, int g, int th, char* smem) {
  u16* sB = (u16*)smem;
  u16* sXT = sB + 128 * 72;
  float* s_dt = (float*)(sXT + 2 * 64 * 136);
  float* s_cum = s_dt + 8 * 128;
  float* s_red = s_cum + 8 * 128;
  const int t = opq(threadIdx.x), lane = t & 63, wave = t >> 6, r = lane & 31, hh = lane >> 5;
  const int tsub = wave & 1, hpair = wave >> 1;
  const u16* BM = (const u16*)(p.ws + OFF_BM); const u16* CM = (const u16*)(p.ws + OFF_CM);
  const u16* Z = (const u16*)(p.ws + OFF_Z);
  u16* MIX = (u16*)(p.ws + OFF_H);
  __syncthreads();
#pragma unroll
  for (int q = 0; q < 2; ++q) {
    const int hd = wave * 2 + q;
    ssd_cum(p, l, b, mc, hd & 1, g * 4 + (hd >> 1), s_dt + hd * 128, s_cum + hd * 128, lane);
  }
  {
    const int row = t >> 1, half = t & 1;
    const u16* src = BM + ((size_t)b * TB + mc * 128 + row) * 128 + g * 64 + half * 32;
#pragma unroll
    for (int c = 0; c < 4; ++c) *(u32x4*)(sB + row * 72 + half * 32 + c * 8) = *(const u32x4*)(src + c * 8);
  }
  const int ltok = th * 64 + tsub * 32 + r;
  const size_t R = (size_t)b * TB + mc * 128 + ltok;
  bf16x8 cf[4];
#pragma unroll
  for (int ks = 0; ks < 4; ++ks) cf[ks] = *(const bf16x8*)(CM + R * 128 + g * 64 + ks * 16 + hh * 8);
  float ssq = 0.f;
#pragma unroll 1
  for (int hl2 = 0; hl2 < 2; ++hl2) {
    __syncthreads();
    stage_xsT(p, b, mc, g * 4 + hl2, sXT, t);
    stage_xsT(p, b, mc, g * 4 + 2 + hl2, sXT + 64 * 136, t);
    __syncthreads();
    const int hl = hpair * 2 + hl2, h = g * 4 + hl;
    const u16* myXT = sXT + hpair * 64 * 136;
    const float dskip = p.in[26][l * 8 + h];
    f32x16 Y[2];
#pragma unroll
    for (int pt = 0; pt < 2; ++pt)
#pragma unroll
      for (int k = 0; k < 16; ++k) Y[pt][k] = 0.f;
#pragma unroll 1
    for (int dir = 0; dir < 2; ++dir) {
      const float cl = s_cum[(hl * 2 + dir) * 128 + ltok];
      const int pc = proc_chunk(mc, dir);
      const float* Sp = (const float*)(p.ws + OFF_R1) + ((size_t)(((b * 2 + dir) * 8 + h) * 66 + pc)) * 4096;
      f32x16 yo[2];
#pragma unroll
      for (int pt = 0; pt < 2; ++pt)
#pragma unroll
        for (int k = 0; k < 16; ++k) yo[pt][k] = 0.f;
#pragma unroll
      for (int ks = 0; ks < 4; ++ks)
#pragma unroll
        for (int pt = 0; pt < 2; ++pt) {
          const float4* sp4 = (const float4*)(Sp + (pt * 32 + r) * 64 + ks * 16 + hh * 8);
          float4 x0 = sp4[0], x1 = sp4[1];
          float tmp[8] = {x0.x, x0.y, x0.z, x0.w, x1.x, x1.y, x1.z, x1.w};
          bf16x8 sf = pack8(tmp);
          yo[pt] = MFMA32(sf, cf[ks], yo[pt]);
        }
      const float ecl = fexp(cl);
#pragma unroll
      for (int pt = 0; pt < 2; ++pt)
#pragma unroll
        for (int k = 0; k < 16; ++k) Y[pt][k] += ecl * yo[pt][k];
    }
#pragma unroll 1
    for (int st = 0; st < 4; ++st) {
      f32x16 cbt;
#pragma unroll
      for (int k = 0; k < 16; ++k) cbt[k] = 0.f;
#pragma unroll
      for (int ks = 0; ks < 4; ++ks) {
        bf16x8 bfrag = *(const bf16x8*)(sB + (st * 32 + r) * 72 + ks * 16 + hh * 8);
        cbt = MFMA32(bfrag, cf[ks], cbt);
      }
#pragma unroll
      for (int dir = 0; dir < 2; ++dir) {
        const float* cumv = s_cum + (hl * 2 + dir) * 128;
        const float* dtv = s_dt + (hl * 2 + dir) * 128;
        const float cl = cumv[ltok];
        float m[16];
#pragma unroll
        for (int k = 0; k < 16; ++k) {
          const int s = st * 32 + crow(k, hh);
          const bool valid = (dir == 0) ? (s <= ltok) : (s >= ltok);
          float val = valid ? cbt[k] * fexp(cl - cumv[s]) * dtv[s] : 0.f;
          if (dir == 0 && s == ltok) val += dskip;
          m[k] = val;
        }
#pragma unroll
        for (int s2 = 0; s2 < 2; ++s2) {
          bf16x8 pf = pack8(m + 8 * s2);
#pragma unroll
          for (int pt = 0; pt < 2; ++pt) {
            const u16* xp = myXT + (pt * 32 + r) * 136 + st * 32 + 16 * s2 + 4 * hh;
            s16x4 lo = *(const s16x4*)xp;
            s16x4 hi = *(const s16x4*)(xp + 8);
            bf16x8 xf = __builtin_shufflevector(lo, hi, 0, 1, 2, 3, 4, 5, 6, 7);
            Y[pt] = MFMA32(xf, pf, Y[pt]);
          }
        }
      }
    }
#pragma unroll
    for (int pt = 0; pt < 2; ++pt)
#pragma unroll
      for (int gq = 0; gq < 4; ++gq) {
        const int ch0 = h * 64 + pt * 32 + 8 * gq + 4 * hh;
        float zv[4];
        ld4bf(Z + R * 512 + ch0, zv);
        float yv[4];
#pragma unroll
        for (int e = 0; e < 4; ++e) { yv[e] = Y[pt][4 * gq + e] * fsilu(zv[e]); ssq += yv[e] * yv[e]; }
        st4bf(MIX + R * DM + 512 + ch0, yv);
      }
  }
  ssq += __shfl_xor(ssq, 32);
  if (hh == 0) s_red[wave * 32 + r] = ssq;
  __syncthreads();
  ssq += s_red[(wave ^ 2) * 32 + r];
  const float rinv = rsqrtf(ssq * (1.0f / 256) + EPS);
  const float* gn = p.in[27] + l * 512;
  for (int hl2 = 0; hl2 < 2; ++hl2) {
    const int h = g * 4 + hpair * 2 + hl2;
#pragma unroll
    for (int pt = 0; pt < 2; ++pt)
#pragma unroll
      for (int gq = 0; gq < 4; ++gq) {
        const int ch0 = h * 64 + pt * 32 + 8 * gq + 4 * hh;
        float yv[4];
        ld4bf(MIX + R * DM + 512 + ch0, yv);
#pragma unroll
        for (int e = 0; e < 4; ++e) yv[e] = yv[e] * rinv * gn[ch0 + e];
        st4bf(MIX + R * DM + 512 + ch0, yv);
      }
  }
}

__global__ void __launch_bounds__(256, 2) fwd_megakernel(Params p) {
  __shared__ __attribute__((aligned(16))) char smem[73728];
  __shared__ uint4 xb_words;
  cg::grid_group grid = cg::this_grid();
  const int bid = blockIdx.x, nb = gridDim.x;
  unsigned* bar = (unsigned*)(p.ws + OFF_BAR);
  if (threadIdx.x == 0) xb_words = make_uint4(0u, 0u, 0u, 0u);
  __syncthreads();
  const XcdBarrier xb = xcd_barrier_post(bar, (volatile LAS unsigned*)&xb_words);
  if (p.ws == nullptr) grid.sync();

  for (int it = bid; it < CV_T5 + 1152 + 1; it += nb) {
    if (it < CV_T5) convert_item(p, 0, it, smem);
    else if (it < CV_T5 + 1152) mods_item(p, it - CV_T5, smem);
    else misc_item(p);
  }
  xcd_barrier(xb);

  for (int l = 0; l < 2; ++l) {
    const bool last = (l == 1);
    if (l == 1) {
      for (int it = bid; it < CV_T5; it += nb) convert_item(p, 1, it, smem);
    }
    normmod_phase(p, l, 0, bid, nb);
    xcd_barrier(xb);
    gemm_phase<0>(p, l, (const u16*)(p.ws + OFF_H), 1024, (const u16*)(p.ws + OFF_W13A), 44, 0.f, 0, smem, bid, nb);
    xcd_barrier(xb);
    gemm_phase<1>(p, l, (const u16*)(p.ws + OFF_R1), 2816, (const u16*)(p.ws + OFF_W2A), 8, 0.5f, 2, smem, bid, nb);
    xcd_barrier(xb);
    normmod_phase(p, l, 1, bid, nb);
    xcd_barrier(xb);
    gemm_phase<2>(p, l, (const u16*)(p.ws + OFF_H), 1024, (const u16*)(p.ws + OFF_WIN), 21, 0.f, 0, smem, bid, nb);
    xcd_barrier(xb);
    postproc_phase(p, l, bid, nb);
    xcd_barrier(xb);
    {
      const int nA = 512, nB = 512, nS = 1056, nAc = last ? 0 : 16, nBc = last ? 0 : 16;
      const int tot = nA + nB + nS + nAc + nBc;
      for (int it0 = bid; it0 < tot; it0 += nb) {
        int j = it0;
        if (j < nA + nB) j = (j & ~511) | ((j & 7) << 6) | ((j >> 3) & 63);
        if (j < nA) { attnA_item(p, l, j >> 8, (j >> 6) & 3, NCTX + (j & 63) * 128, TB, smem); continue; }
        j -= nA;
        if (j < nB) { attnB_item(p, l, j >> 8, (j >> 6) & 3, j & 63, false); continue; }
        j -= nB;
        if (j < nS) { ssd1_item(p, l, j / 528, (j % 528) >> 3, j & 7, smem); continue; }
        j -= nS;
        if (j < nAc) { attnA_item(p, l, j >> 3, (j >> 1) & 3, (j & 1) * 128, NCTX, smem); continue; }
        j -= nAc;
        attnB_item(p, l, j >> 3, (j >> 1) & 3, j & 1, true);
      }
    }
    xcd_barrier(xb);
    ssd2_phase(p, bid, nb);
    xcd_barrier(xb);
    {
      const int skip = last ? 8 : 0;
      for (int it = bid; it < 2 * (264 - skip); it += nb) {
        const int b = it / (264 - skip), rem = it % (264 - skip) + skip, mc = rem >> 2, g = (rem >> 1) & 1, th = rem & 1;
        ssd3_item(p, l, b, mc, g, th, smem);
      }
    }
    xcd_barrier(xb);
    gemm_phase<1>(p, l, (const u16*)(p.ws + OFF_H), 1024, (const u16*)(p.ws + OFF_WOUT), 8, 1.0f, 5, smem, bid, nb);
    xcd_barrier(xb);
    normmod_phase(p, l, 2, bid, nb);
    xcd_barrier(xb);
    gemm_phase<0>(p, l, (const u16*)(p.ws + OFF_H), 1024, (const u16*)(p.ws + OFF_W13B), 44, 0.f, 0, smem, bid, nb);
    xcd_barrier(xb);
    gemm_phase<1>(p, l, (const u16*)(p.ws + OFF_R1), 2816, (const u16*)(p.ws + OFF_W2B), 8, 0.5f, 8, smem, bid, nb);
    if (!last) xcd_barrier(xb);
  }
}

extern "C" void kernel_launch(void* const* d_in, const int* in_sizes, int n_in, void* d_out, int out_size,
                              void* d_ws, size_t ws_size, hipStream_t stream) {
  static int grid_blocks = 0;
  if (!grid_blocks) {
    int dev = 0, cus = 0, per_cu = 0;
    (void)hipGetDevice(&dev);
    (void)hipDeviceGetAttribute(&cus, hipDeviceAttributeMultiprocessorCount, dev);
    (void)hipOccupancyMaxActiveBlocksPerMultiprocessor(&per_cu, fwd_megakernel, 256, 0);
    if (per_cu > 2) per_cu = 2;
    if (per_cu < 1) per_cu = 1;
    grid_blocks = cus * per_cu;
  }
  if (ws_size < WS_TOTAL) { fprintf(stderr, "workspace too small: %zu < %zu\n", ws_size, (size_t)WS_TOTAL); return; }
  Params p{};
  for (int i = 0; i < 31; ++i) p.in[i] = (const float*)d_in[i];
  p.out = (float*)d_out;
  p.ws = (char*)d_ws;
  (void)hipMemsetAsync((char*)d_ws + OFF_BAR, 0, XCD_BAR_WORDS * sizeof(unsigned), stream);
  void* args[] = {&p};
  hipError_t e = hipLaunchCooperativeKernel((void*)fwd_megakernel, dim3(grid_blocks), dim3(256), args, 0, stream);
  if (e != hipSuccess) fprintf(stderr, "cooperative launch failed: %s (grid %d)\n", hipGetErrorString(e), grid_blocks);
}
```

```cpp
#include <hip/hip_runtime.h>
#include <hip/hip_cooperative_groups.h>
#include <cstdio>
namespace cg = cooperative_groups;

typedef __attribute__((ext_vector_type(8))) short bf16x8;
typedef __attribute__((ext_vector_type(4))) short s16x4;
typedef __attribute__((ext_vector_type(16))) float f32x16;
typedef __attribute__((ext_vector_type(2))) float f32x2;
typedef __attribute__((ext_vector_type(2))) __bf16 bf16x2_t;
typedef unsigned short u16;
typedef __attribute__((ext_vector_type(4))) unsigned u32x4;
#define DI __device__ __forceinline__
#define MFMA32(a, b, c) __builtin_amdgcn_mfma_f32_32x32x16_bf16((a), (b), (c), 0, 0, 0)

constexpr int TB = 8448, TR = 16896, DM = 1024, DFF = 2816, PST = 2560, NCTX = 256;
constexpr float LOG2E = 1.4426950408889634f;
constexpr float EPS = 1e-6f;

constexpr size_t al256(size_t x) { return (x + 255) & ~(size_t)255; }
constexpr size_t OFF_XC = 0;
constexpr size_t OFF_H = al256(OFF_XC + (size_t)512 * 1024 * 4);
constexpr size_t OFF_R1 = al256(OFF_H + (size_t)TR * 1024 * 2);
constexpr size_t OFF_DTRAW = al256(OFF_R1 + (size_t)TR * DFF * 2);
constexpr size_t OFF_QA = al256(OFF_DTRAW + (size_t)TR * 16 * 4);
constexpr size_t OFF_KA = al256(OFF_QA + (size_t)TR * 256 * 2);
constexpr size_t OFF_VAT = al256(OFF_KA + (size_t)TR * 256 * 2);
constexpr size_t OFF_QB = al256(OFF_VAT + (size_t)TR * 256 * 2);
constexpr size_t OFF_KB = al256(OFF_QB + (size_t)TR * 256 * 2);
constexpr size_t OFF_VBT = al256(OFF_KB + (size_t)TR * 128 * 2);
constexpr size_t OFF_Z = al256(OFF_VBT + (size_t)TR * 128 * 2);
constexpr size_t OFF_XS = al256(OFF_Z + (size_t)TR * 512 * 2);
constexpr size_t OFF_BM = al256(OFF_XS + (size_t)TR * 512 * 2);
constexpr size_t OFF_CM = al256(OFF_BM + (size_t)TR * 128 * 2);
constexpr size_t OFF_DT = al256(OFF_CM + (size_t)TR * 128 * 2);
constexpr size_t OFF_ATOT = al256(OFF_DT + (size_t)TR * 16 * 4);
constexpr size_t OFF_MODS = al256(OFF_ATOT + (size_t)32 * 66 * 4);
constexpr size_t OFF_MISC = al256(OFF_MODS + (size_t)2 * 3 * 9216 * 4);
constexpr size_t OFF_BAR = al256(OFF_MISC + 256);
constexpr size_t OFF_W13A = al256(OFF_BAR + 3456 * 4);
constexpr size_t OFF_W2A = al256(OFF_W13A + (size_t)5632 * 1024 * 2);
constexpr size_t OFF_WIN = al256(OFF_W2A + (size_t)1024 * 2816 * 2);
constexpr size_t OFF_WOUT = al256(OFF_WIN + (size_t)2688 * 1024 * 2);
constexpr size_t OFF_W13B = al256(OFF_WOUT + (size_t)1024 * 1024 * 2);
constexpr size_t OFF_W2B = al256(OFF_W13B + (size_t)5632 * 1024 * 2);
constexpr size_t WS_TOTAL = al256(OFF_W2B + (size_t)1024 * 2816 * 2);

struct Params {
  const float* in[31];
  float* out;
  char* ws;
};

DI unsigned pk2(float a, float b) { f32x2 v = {a, b}; return __builtin_bit_cast(unsigned, __builtin_convertvector(v, bf16x2_t)); }
DI u16 f2bf(float a) { return __builtin_bit_cast(u16, (__bf16)a); }
DI float bf2f(u16 h) { return __uint_as_float(((unsigned)h) << 16); }
DI float bflo(unsigned u) { return __uint_as_float(u << 16); }
DI float bfhi(unsigned u) { return __uint_as_float(u & 0xffff0000u); }
DI int opq(int x) { asm volatile("" : "+v"(x)); return x; }
DI int crow(int i, int hh) { return (i & 3) + 8 * (i >> 2) + 4 * hh; }
DI float fexp(float x) { return __builtin_amdgcn_exp2f(x * LOG2E); }
DI float fsilu(float x) { return x * __builtin_amdgcn_rcpf(1.0f + fexp(-x)); }
DI float wave_sum(float v) {
#pragma unroll
  for (int off = 32; off > 0; off >>= 1) v += __shfl_xor(v, off);
  return v;
}
DI bf16x8 pack8(const float* p) {
  uint4 u;
  u.x = pk2(p[0], p[1]); u.y = pk2(p[2], p[3]); u.z = pk2(p[4], p[5]); u.w = pk2(p[6], p[7]);
  return __builtin_bit_cast(bf16x8, u);
}
DI float* stream_row(const Params& p, int b, int i) {
  return (i < NCTX) ? (float*)(p.ws + OFF_XC) + (size_t)(b * NCTX + i) * DM : p.out + ((size_t)b * 8192 + (i - NCTX)) * DM;
}
DI const float* input_row(const Params& p, int b, int i) {
  return (i < NCTX) ? p.in[2] + (size_t)(b * NCTX + i) * DM : p.in[0] + ((size_t)b * 8192 + (i - NCTX)) * DM;
}


#define XB_TMO      128
#define XB_XCNT(j)  (256  + 64 * (j))
#define XB_XSUB(j)  (1280 + 64 * (j))
#define XB_XGEN(j)  (2304 + 64 * (j))
#define XB_TOP      3328
#define XB_TOPGEN   3392
#define XCD_BAR_WORDS 3456
#define XB_SPIN_CAP (1u << 18)
#define LAS __attribute__((address_space(3)))
DI unsigned xb_ld(unsigned* p)              { return __hip_atomic_load(p, __ATOMIC_RELAXED, __HIP_MEMORY_SCOPE_AGENT); }
DI unsigned xb_add(unsigned* p, unsigned v) { return __hip_atomic_fetch_add(p, v, __ATOMIC_RELAXED, __HIP_MEMORY_SCOPE_AGENT); }
DI unsigned xb_xcc_id() { return (unsigned)__builtin_amdgcn_s_getreg((3 << 11) | 20) & 0xFu; }
#define XB_SPIN(cond, bar) do { unsigned _sp = 0; while (cond) { __builtin_amdgcn_s_sleep(1); \
    if ((++_sp & 255u) == 0u) { if (xb_ld(&(bar)[XB_TMO])) break; if (_sp > XB_SPIN_CAP) { atomicAdd(&(bar)[XB_TMO], 1u); break; } } } } while (0)
struct XcdBarrier { unsigned* bar; unsigned x; volatile LAS unsigned* st; };
DI XcdBarrier xcd_barrier_post(unsigned* bar, volatile LAS unsigned* st) {
  XcdBarrier b; b.bar = bar; b.x = xb_xcc_id(); b.st = st;
  if (threadIdx.x == 0) (void)xb_add(&bar[XB_XCNT(b.x)], 1u);
  return b;
}
DI void xcd_barrier_complete(unsigned* bar, unsigned x, unsigned& nloc, unsigned& nx) {
  const unsigned G = gridDim.x * gridDim.y * gridDim.z;
  unsigned sum, cnt, mine, sp = 0u;
  for (;;) {
    sum = 0u; cnt = 0u; mine = 0u;
#pragma unroll
    for (unsigned j = 0; j < 16; ++j) { const unsigned c = xb_ld(&bar[XB_XCNT(j)]); sum += c; cnt += (c > 0u) ? 1u : 0u; mine = (j == x) ? c : mine; }
    if (sum == G) break;
    __builtin_amdgcn_s_sleep(1);
    if ((++sp & 255u) == 0u) { if (xb_ld(&bar[XB_TMO])) break; if (sp > XB_SPIN_CAP) { atomicAdd(&bar[XB_TMO], 1u); break; } }
  }
  nloc = mine > 0u ? mine : 1u; nx = cnt > 0u ? cnt : 1u;
}
DI void xcd_barrier(const XcdBarrier& b) {
  asm volatile("s_waitcnt vmcnt(0)" ::: "memory");
  __syncthreads();
  if (threadIdx.x == 0) {
    unsigned* bar = b.bar;
    __builtin_amdgcn_s_waitcnt(0);
    unsigned nloc = b.st[0], nx = b.st[1];
    if (nloc == 0u) { xcd_barrier_complete(bar, b.x, nloc, nx); b.st[0] = nloc; b.st[1] = nx; }
    const unsigned old = xb_add(&bar[XB_XSUB(b.x)], 1u);
    const unsigned gen = old / nloc;
    if (old + 1u == (gen + 1u) * nloc) {
      __builtin_amdgcn_fence(__ATOMIC_RELEASE, "agent");
      asm volatile("s_waitcnt vmcnt(0)" ::: "memory");
      const unsigned og = xb_add(&bar[XB_TOP], 1u);
      const unsigned tg = og / nx;
      if (og + 1u == (tg + 1u) * nx) xb_add(&bar[XB_TOPGEN], 1u);
      else XB_SPIN(xb_ld(&bar[XB_TOPGEN]) == tg, bar);
      __builtin_amdgcn_fence(__ATOMIC_ACQUIRE, "agent");
      xb_add(&bar[XB_XGEN(b.x)], 1u);
      asm volatile("s_waitcnt vmcnt(0)" ::: "memory");
    } else {
      XB_SPIN(xb_ld(&bar[XB_XGEN(b.x)]) == gen, bar);
      __builtin_amdgcn_fence(__ATOMIC_ACQUIRE, "agent");
      asm volatile("s_waitcnt vmcnt(0)" ::: "memory");
    }
  }
  __syncthreads();
}

DI void convert_tile(const float* __restrict__ src, u16* __restrict__ dst, int K, int N, int ntn, int idx, bool swiglu_perm, char* smem) {
  float* tile = (float*)smem;
  const int t = opq(threadIdx.x);
  const int kt = idx / ntn, nt = idx % ntn, k0 = kt * 64, n0 = nt * 64;
  {
    const int col = t & 63, r0 = t >> 6;
    const int n = n0 + col;
    float vv[16];
#pragma unroll
    for (int q = 0; q < 16; ++q) vv[q] = (n < N) ? __builtin_nontemporal_load(&src[(size_t)(k0 + r0 + 4 * q) * N + n]) : 0.0f;
#pragma unroll
    for (int q = 0; q < 16; ++q) tile[col * 65 + r0 + 4 * q] = vv[q];
  }
  __syncthreads();
  {
    const int kp = t & 31, nn0 = t >> 5;
#pragma unroll
    for (int j = 0; j < 8; ++j) {
      const int nn = nn0 + 8 * j, n = n0 + nn;
      int np = n;
      if (swiglu_perm) {
        if (n < DFF) np = (n >> 5) * 64 + (n & 31);
        else { int jj = n - DFF; np = (jj >> 5) * 64 + 32 + (jj & 31); }
      }
      unsigned v = pk2(tile[nn * 65 + 2 * kp], tile[nn * 65 + 2 * kp + 1]);
      *(unsigned*)(dst + (size_t)np * K + k0 + 2 * kp) = v;
    }
  }
  __syncthreads();
}

constexpr int CV_T0 = 1408, CV_T1 = CV_T0 + 704, CV_T2 = CV_T1 + 672, CV_T3 = CV_T2 + 256, CV_T4 = CV_T3 + 1408, CV_T5 = CV_T4 + 704;

DI void convert_item(const Params& p, int l, int idx, char* smem) {
  if (idx < CV_T0) convert_tile(p.in[7] + (size_t)l * 1024 * 5632, (u16*)(p.ws + OFF_W13A), 1024, 5632, 88, idx, true, smem);
  else if (idx < CV_T1) convert_tile(p.in[8] + (size_t)l * 2816 * 1024, (u16*)(p.ws + OFF_W2A), 2816, 1024, 16, idx - CV_T0, false, smem);
  else if (idx < CV_T2) convert_tile(p.in[10] + (size_t)l * 1024 * 2576, (u16*)(p.ws + OFF_WIN), 1024, 2576, 42, idx - CV_T1, false, smem);
  else if (idx < CV_T3) convert_tile(p.in[11] + (size_t)l * 1024 * 1024, (u16*)(p.ws + OFF_WOUT), 1024, 1024, 16, idx - CV_T2, false, smem);
  else if (idx < CV_T4) convert_tile(p.in[29] + (size_t)l * 1024 * 5632, (u16*)(p.ws + OFF_W13B), 1024, 5632, 88, idx - CV_T3, true, smem);
  else convert_tile(p.in[30] + (size_t)l * 2816 * 1024, (u16*)(p.ws + OFF_W2B), 2816, 1024, 16, idx - CV_T4, false, smem);
}

DI void mods_item(const Params& p, int idx, char* smem) {
  float* sv = (float*)smem;
  float* red = sv + 3072;
  const int t = opq(threadIdx.x);
  const int l = idx / 576, n0 = (idx % 576) * 16;
  for (int e = t; e < 3072; e += 256) {
    int v = e >> 10, k = e & 1023;
    float xv = (v < 2) ? p.in[1][v * 1024 + k] : p.in[3][k];
    sv[e] = fsilu(xv);
  }
  __syncthreads();
  const int c = t & 15, kg = t >> 4;
  const float* w = p.in[4] + (size_t)l * 1024 * 9216 + n0 + c;
  float a0 = 0.f, a1 = 0.f, a2 = 0.f;
#pragma unroll 32
  for (int k = kg * 64; k < kg * 64 + 64; ++k) {
    float wv = __builtin_nontemporal_load(&w[(size_t)k * 9216]);
    a0 += sv[k] * wv; a1 += sv[1024 + k] * wv; a2 += sv[2048 + k] * wv;
  }
  red[(kg * 3 + 0) * 16 + c] = a0; red[(kg * 3 + 1) * 16 + c] = a1; red[(kg * 3 + 2) * 16 + c] = a2;
  __syncthreads();
  if (t < 48) {
    int v = t >> 4, cc = t & 15;
    float s = p.in[5][l * 9216 + n0 + cc];
#pragma unroll
    for (int g = 0; g < 16; ++g) s += red[(g * 3 + v) * 16 + cc];
    ((float*)(p.ws + OFF_MODS))[(l * 3 + v) * 9216 + n0 + cc] = s;
  }
  __syncthreads();
}

DI void misc_item(const Params& p) {
  const int t_ = opq(threadIdx.x);
  if (t_ < 2) {
    const int l = t_;
    float s1 = 0.f, s2 = 0.f, mqa = 0.f, mka = 0.f;
    for (int i = 0; i < 32; ++i) {
      s1 += p.in[14][l * 32 + i] * p.in[15][l * 32 + i];
      s2 += p.in[16][l * 32 + i] * p.in[17][l * 32 + i];
      mqa = fmaxf(mqa, fabsf(p.in[12][l * 32 + i]));
      mka = fmaxf(mka, fabsf(p.in[13][l * 32 + i]));
    }
    float mqb = 0.f, mkb = 0.f;
    for (int i = 0; i < 64; ++i) {
      mqb = fmaxf(mqb, fabsf(p.in[19][l * 64 + i]));
      mkb = fmaxf(mkb, fabsf(p.in[20][l * 64 + i]));
    }
    float lam_init = 0.8f - 0.6f * expf(-0.3f * (float)l);
    float* m = (float*)(p.ws + OFF_MISC);
    m[l * 4 + 0] = expf(s1) - expf(s2) + lam_init;
    m[l * 4 + 1] = lam_init;
    m[l * 4 + 2] = 32.0f * mqa * mka * 0.17677669529663687f * LOG2E * 1.01f;
    m[l * 4 + 3] = 64.0f * mqb * mkb * 0.125f * LOG2E * 1.01f;
  }
}

DI void normmod_phase(const Params& p, int l, int which, int bid, int nb) {
  const float* nw = p.in[which == 0 ? 6 : (which == 1 ? 9 : 28)] + l * DM;
  const int t_ = opq(threadIdx.x);
  const int wave = t_ >> 6, lane = t_ & 63;
  u16* H = (u16*)(p.ws + OFF_H);
  const bool from_input = (l == 0 && which == 0);
  for (int R = bid * 4 + wave; R < TR; R += nb * 4) {
    const int b = R / TB, i = R % TB;
    const bool isctx = i < NCTX;
    const float* src = from_input ? input_row(p, b, i) : stream_row(p, b, i);
    const float* mod = (const float*)(p.ws + OFF_MODS) + (size_t)(l * 3 + (isctx ? 2 : b)) * 9216;
    const float* shift = mod + (which * 3) * DM;
    const float* scale = mod + (which * 3 + 1) * DM;
    float4 v[4];
    float ss = 0.f;
#pragma unroll
    for (int j = 0; j < 4; ++j) {
      v[j] = ((const float4*)src)[lane + 64 * j];
      ss += v[j].x * v[j].x + v[j].y * v[j].y + v[j].z * v[j].z + v[j].w * v[j].w;
    }
    ss = wave_sum(ss);
    const float rinv = rsqrtf(ss * (1.0f / DM) + EPS);
    if (from_input) {
      float* dstrow = stream_row(p, b, i);
#pragma unroll
      for (int j = 0; j < 4; ++j) ((float4*)dstrow)[lane + 64 * j] = v[j];
    }
#pragma unroll
    for (int j = 0; j < 4; ++j) {
      const int c4 = lane + 64 * j;
      float4 w4 = ((const float4*)nw)[c4], sh = ((const float4*)shift)[c4], sc = ((const float4*)scale)[c4];
      float y0 = v[j].x * rinv * w4.x * (1.0f + sc.x) + sh.x;
      float y1 = v[j].y * rinv * w4.y * (1.0f + sc.y) + sh.y;
      float y2 = v[j].z * rinv * w4.z * (1.0f + sc.z) + sh.z;
      float y3 = v[j].w * rinv * w4.w * (1.0f + sc.w) + sh.w;
      uint2 o; o.x = pk2(y0, y1); o.y = pk2(y2, y3);
      *(uint2*)(H + (size_t)R * DM + c4 * 4) = o;
    }
  }
}

constexpr int G_LD = 40, G_STAGE = 384 * G_LD;
DI void gemm_gload(u32x4 (&ra)[4], u32x4 (&rb)[2], const u16* __restrict__ Agt, const u16* __restrict__ Bgt, int K, int kt) {
#pragma unroll
  for (int j = 0; j < 4; ++j) ra[j] = *(const u32x4*)(Agt + (size_t)(64 * j) * K + kt * 32);
#pragma unroll
  for (int j = 0; j < 2; ++j) rb[j] = *(const u32x4*)(Bgt + (size_t)(64 * j) * K + kt * 32);
}
DI void gemm_sstore(const u32x4 (&ra)[4], const u32x4 (&rb)[2], u16* sAt, u16* sBt) {
#pragma unroll
  for (int j = 0; j < 4; ++j) *(u32x4*)(sAt + 64 * j * G_LD) = ra[j];
#pragma unroll
  for (int j = 0; j < 2; ++j) *(u32x4*)(sBt + 64 * j * G_LD) = rb[j];
}
template <bool SWAP>
DI void gemm_compute(f32x16 (&acc)[4][2], const u16* a_, const u16* b_, int wm, int wn, int r, int hh) {
#pragma unroll
  for (int kk = 0; kk < 2; ++kk) {
    bf16x8 af[4], bfr[2];
#pragma unroll
    for (int mi = 0; mi < 4; ++mi) af[mi] = *(const bf16x8*)(a_ + (wm * 128 + mi * 32 + r) * G_LD + kk * 16 + hh * 8);
#pragma unroll
    for (int ni = 0; ni < 2; ++ni) bfr[ni] = *(const bf16x8*)(b_ + (wn * 64 + ni * 32 + r) * G_LD + kk * 16 + hh * 8);
#pragma unroll
    for (int mi = 0; mi < 4; ++mi)
#pragma unroll
      for (int ni = 0; ni < 2; ++ni) acc[mi][ni] = SWAP ? MFMA32(bfr[ni], af[mi], acc[mi][ni]) : MFMA32(af[mi], bfr[ni], acc[mi][ni]);
  }
  __builtin_amdgcn_iglp_opt(0);
}
template <bool SWAP>
DI void gemm_tile_kloop(f32x16 (&acc)[4][2], const u16* __restrict__ A, const u16* __restrict__ Bt, int K, int mt, int nt, int k0, int k1,
                        char* smem, int t, int wm, int wn, int r, int hh) {
#pragma unroll
  for (int a = 0; a < 4; ++a)
#pragma unroll
    for (int c = 0; c < 2; ++c)
#pragma unroll
      for (int i = 0; i < 16; ++i) acc[a][c][i] = 0.f;
  u16* sm = (u16*)smem;
  const int lrow = t >> 2, lkc = (t & 3) * 8;
  const u16* Agt = A + (size_t)(mt * 256 + lrow) * K + lkc;
  const u16* Bgt = Bt + (size_t)(nt * 128 + lrow) * K + lkc;
  u16* sAt = sm + lrow * G_LD + lkc;
  u16* sBt = sm + 256 * G_LD + lrow * G_LD + lkc;
  u32x4 ra0[4], rb0[2], ra1[4], rb1[2];
  gemm_gload(ra0, rb0, Agt, Bgt, K, k0);
  gemm_sstore(ra0, rb0, sAt, sBt);
  gemm_gload(ra1, rb1, Agt, Bgt, K, k0 + 1);
  __syncthreads();
  for (int kt = k0; kt < k1; kt += 2) {
    gemm_compute<SWAP>(acc, sm, sm + 256 * G_LD, wm, wn, r, hh);
    gemm_sstore(ra1, rb1, sAt + G_STAGE, sBt + G_STAGE);
    gemm_gload(ra0, rb0, Agt, Bgt, K, min(kt + 2, k1 - 1));
    __syncthreads();
    gemm_compute<SWAP>(acc, sm + G_STAGE, sm + G_STAGE + 256 * G_LD, wm, wn, r, hh);
    gemm_sstore(ra0, rb0, sAt, sBt);
    gemm_gload(ra1, rb1, Agt, Bgt, K, min(kt + 3, k1 - 1));
    __syncthreads();
  }
}

DI void st4bf_(u16* ptr, float a, float b, float c, float d) { uint2 u; u.x = pk2(a, b); u.y = pk2(c, d); *(uint2*)ptr = u; }
DI void epi_win(const Params& p, int l, f32x16 (&acc)[4][2], int mt, int nt, int wm, int wn, int r_, int hh_) {
  const int r = opq(r_), hh = opq(hh_);
  const int b = (mt * 256) / TB, i0 = (mt * 256) % TB;
  const bool isctx = i0 < NCTX;
#pragma unroll
  for (int mi = 0; mi < 4; ++mi) {
    const int itok = i0 + wm * 128 + mi * 32 + r;
    const size_t R = (size_t)b * TB + itok;
    const int tpos = itok - NCTX;
    const float rowp = (float)(tpos >> 6), colp = (float)(tpos & 63);
    if (nt < 4) {
      const bool isq = nt < 2;
      const float* w = p.in[isq ? 12 : 13] + l * 32;
      u16* dst = (u16*)(p.ws + (isq ? OFF_QA : OFF_KA)) + R * 256 + (nt & 1) * 128 + wn * 64;
      const float osc = isq ? 0.17677669529663687f * LOG2E : 1.0f;
#pragma unroll
      for (int ni = 0; ni < 2; ++ni) {
        f32x16& v = acc[mi][ni];
        float ss = 0.f;
#pragma unroll
        for (int i = 0; i < 16; ++i) ss += v[i] * v[i];
        ss += __shfl_xor(ss, 32);
        const float rinv = rsqrtf(ss * (1.0f / 32) + EPS);
#pragma unroll
        for (int i = 0; i < 16; ++i) v[i] *= rinv * w[crow(i, hh)];
        if (!isctx) {
#pragma unroll
          for (int g2 = 0; g2 < 2; ++g2)
#pragma unroll
            for (int e = 0; e < 4; ++e) {
              const int i = 8 * g2 + e;
              const float idx = (float)(e + 4 * hh);
              const float ang = (g2 == 0 ? rowp : colp) * __builtin_amdgcn_exp2f(-idx * (13.287712379549449f / 8));
              const float c = __cosf(ang), s = __sinf(ang);
              const float a = v[i], bb = v[i + 4];
              v[i] = a * c - bb * s;
              v[i + 4] = bb * c + a * s;
            }
        }
#pragma unroll
        for (int g = 0; g < 4; ++g) st4bf_(dst + ni * 32 + 8 * g + 4 * hh, v[4 * g] * osc, v[4 * g + 1] * osc, v[4 * g + 2] * osc, v[4 * g + 3] * osc);
      }
    } else if (nt < 6) {
      u16* VAT = (u16*)(p.ws + OFF_VAT);
#pragma unroll
      for (int ni = 0; ni < 2; ++ni)
#pragma unroll
        for (int i = 0; i < 16; ++i) {
          const int ch = (nt - 4) * 128 + wn * 64 + ni * 32 + crow(i, hh);
          VAT[((size_t)b * 256 + ch) * TB + itok] = f2bf(acc[mi][ni][i]);
        }
    } else if (nt < 9) {
      const bool isq = nt < 8;
      const float* w = p.in[isq ? 19 : 20] + l * 64;
      u16* dst = isq ? (u16*)(p.ws + OFF_QB) + R * 256 + ((nt - 6) * 2 + wn) * 64 : (u16*)(p.ws + OFF_KB) + R * 128 + wn * 64;
      const float osc = isq ? 0.125f * LOG2E : 1.0f;
      f32x16 (&v)[2] = acc[mi];
      float ss = 0.f;
#pragma unroll
      for (int ni = 0; ni < 2; ++ni)
#pragma unroll
        for (int i = 0; i < 16; ++i) ss += v[ni][i] * v[ni][i];
      ss += __shfl_xor(ss, 32);
      const float rinv = rsqrtf(ss * (1.0f / 64) + EPS);
#pragma unroll
      for (int ni = 0; ni < 2; ++ni)
#pragma unroll
        for (int i = 0; i < 16; ++i) v[ni][i] *= rinv * w[ni * 32 + crow(i, hh)];
      if (!isctx) {
#pragma unroll
        for (int ni = 0; ni < 2; ++ni)
#pragma unroll
          for (int i = 0; i < 8; ++i) {
            const float idx = (float)crow(i, hh);
            const float ang = (ni == 0 ? rowp : colp) * __builtin_amdgcn_exp2f(-idx * (13.287712379549449f / 16));
            const float c = __cosf(ang), s = __sinf(ang);
            const float a = v[ni][i], bb = v[ni][i + 8];
            v[ni][i] = a * c - bb * s;
            v[ni][i + 8] = bb * c + a * s;
          }
      }
#pragma unroll
      for (int ni = 0; ni < 2; ++ni)
#pragma unroll
        for (int g = 0; g < 4; ++g)
          st4bf_(dst + ni * 32 + 8 * g + 4 * hh, v[ni][4 * g] * osc, v[ni][4 * g + 1] * osc, v[ni][4 * g + 2] * osc, v[ni][4 * g + 3] * osc);
    } else if (nt == 9) {
      u16* VBT = (u16*)(p.ws + OFF_VBT);
#pragma unroll
      for (int ni = 0; ni < 2; ++ni)
#pragma unroll
        for (int i = 0; i < 16; ++i) {
          const int ch = wn * 64 + ni * 32 + crow(i, hh);
          VBT[((size_t)b * 128 + ch) * TB + itok] = f2bf(acc[mi][ni][i]);
        }
    } else if (nt < 20) {
      u16* dst = (nt < 14) ? (u16*)(p.ws + OFF_Z) + R * 512 + (nt - 10) * 128 + wn * 64
                           : (u16*)(p.ws + OFF_R1) + R * 768 + (nt - 14) * 128 + wn * 64;
#pragma unroll
      for (int ni = 0; ni < 2; ++ni)
#pragma unroll
        for (int g = 0; g < 4; ++g)
          st4bf_(dst + ni * 32 + 8 * g + 4 * hh, acc[mi][ni][4 * g], acc[mi][ni][4 * g + 1], acc[mi][ni][4 * g + 2], acc[mi][ni][4 * g + 3]);
    } else {
      if (wn == 0) {
        float* DT = (float*)(p.ws + OFF_DT);
#pragma unroll
        for (int i = 0; i < 8; ++i) {
          const int c = crow(i, hh);
          const float x = acc[mi][0][i] + p.in[24][l * 16 + c];
          const float y = fexp(x);
          DT[R * 16 + c] = (x > 15.f) ? x : ((y < 1e-3f) ? (y - 0.5f * y * y) : logf(1.0f + y));
        }
      }
    }
    __builtin_amdgcn_sched_barrier(0);
  }
}

template <int EPI>
DI void gemm_phase(const Params& p, int l, const u16* __restrict__ A, int K, const u16* __restrict__ Bt, int ntn,
                   float coef, int gate_chunk, char* smem, int bid, int nb) {
  const int t = opq(threadIdx.x), lane = t & 63, wave = t >> 6, wm = wave >> 1, wn = wave & 1, r = lane & 31, hh = lane >> 5;
  const int ntiles = 66 * ntn;
  const int nk = K / 32;
  const int xcd = bid & 7, jloc = bid >> 3, chunk = nb >> 3;
  f32x16 acc[4][2];
  if (EPI == 1) {
    const int nk2 = nk >> 1;
    const long U = (long)ntiles * nk2;
    const int ord = xcd * chunk + jloc;
    long u = U * ord / nb;
    const long u_end = U * (ord + 1) / nb;
    while (u < u_end) {
      const int tile = (int)(u / nk2), kk0 = (int)(u % nk2);
      const int cnt = (int)min((long)(nk2 - kk0), u_end - u);
      const int mt = tile / ntn, nt = tile % ntn;
      gemm_tile_kloop<false>(acc, A, Bt, K, mt, nt, kk0 * 2, (kk0 + cnt) * 2, smem, t, wm, wn, r, hh);
      const int b = (mt * 256) / TB, i0 = (mt * 256) % TB;
      const bool isctx = i0 < NCTX;
      const float* gate = (const float*)(p.ws + OFF_MODS) + (size_t)(l * 3 + (isctx ? 2 : b)) * 9216 + gate_chunk * DM;
      float* tbase = stream_row(p, b, i0);
      const int re = opq(r), he = opq(hh);
#pragma unroll
      for (int ni = 0; ni < 2; ++ni) {
        const int col = nt * 128 + wn * 64 + ni * 32 + re;
        const float gc = coef * gate[col];
        const unsigned voff = (unsigned)((wm * 128 + 4 * he) * DM + col);
#pragma unroll
        for (int mi = 0; mi < 4; ++mi)
#pragma unroll
          for (int i = 0; i < 16; ++i)
            unsafeAtomicAdd(tbase + (voff + (unsigned)((mi * 32 + (i & 3) + 8 * (i >> 2)) * DM)), gc * acc[mi][ni][i]);
      }
      u += cnt;
    }
    return;
  }
  for (int cidx = xcd; cidx * chunk < ntiles; cidx += 8) {
    const int o = cidx * chunk + jloc;
    if (o >= ntiles) break;
    int mt, nt;
    if (o < 64 * ntn) { const int grp = o / (8 * ntn), within = o % (8 * ntn); nt = within >> 3; mt = grp * 8 + (within & 7); }
    else { const int within = o - 64 * ntn; nt = within >> 1; mt = 64 + (within & 1); }
    gemm_tile_kloop<EPI == 2>(acc, A, Bt, K, mt, nt, 0, nk, smem, t, wm, wn, r, hh);
    const int row_base = mt * 256 + wm * 128;
    if (EPI == 0) {
      u16* tbase = (u16*)(p.ws + OFF_R1) + (size_t)(mt * 256) * DFF;
      const int re = opq(r), he = opq(hh);
      const unsigned voff = (unsigned)((wm * 128 + 4 * he) * DFF + (nt * 128 + wn * 64) / 2 + re);
#pragma unroll
      for (int mi = 0; mi < 4; ++mi)
#pragma unroll
        for (int i = 0; i < 16; ++i) {
          const float g = acc[mi][0][i], u = acc[mi][1][i];
          tbase[voff + (unsigned)((mi * 32 + (i & 3) + 8 * (i >> 2)) * DFF)] = f2bf(fsilu(g) * u);
        }
    } else {
      epi_win(p, l, acc, mt, nt, wm, wn, r, hh);
    }
  }
}

DI void cv4bf(uint2 u, float (&v)[4]) { v[0] = bflo(u.x); v[1] = bfhi(u.x); v[2] = bflo(u.y); v[3] = bfhi(u.y); }
DI void ld4bf(const u16* ptr, float (&v)[4]) { cv4bf(*(const uint2*)ptr, v); }
DI void st4bf(u16* ptr, const float (&v)[4]) {
  uint2 u; u.x = pk2(v[0], v[1]); u.y = pk2(v[2], v[3]);
  *(uint2*)ptr = u;
}
DI void postproc_phase(const Params& p, int l, int bid, int nb) {
  const int t_ = opq(threadIdx.x);
  const int wave = t_ >> 6, lane = t_ & 63;
  const u16* XR = (const u16*)(p.ws + OFF_R1);
  u16* XS = (u16*)(p.ws + OFF_XS); u16* BM = (u16*)(p.ws + OFF_BM); u16* CM = (u16*)(p.ws + OFF_CM);
  const float* conv_w = p.in[22] + (size_t)l * 5 * 768; const float* conv_b = p.in[23] + l * 768;
  float4 cw[3][5], cb[3];
#pragma unroll
  for (int pass = 0; pass < 3; ++pass) {
    cb[pass] = *(const float4*)(conv_b + pass * 256 + lane * 4);
#pragma unroll
    for (int j = 0; j < 5; ++j) cw[pass][j] = *(const float4*)(conv_w + j * 768 + pass * 256 + lane * 4);
  }
  for (int R = bid * 4 + wave; R < TR; R += nb * 4) {
    const int b = R / TB, i = R % TB;
    const bool isctx = i < NCTX;
    uint2 ucv[3][5];
#pragma unroll
    for (int j = 0; j < 5; ++j) {
      const int ii = i + j - 2;
      const bool valid = isctx ? (ii >= 0 && ii < NCTX) : (ii >= NCTX && ii < TB);
      const u16* src = XR + (size_t)(b * TB + (valid ? ii : i)) * 768 + lane * 4;
#pragma unroll
      for (int pass = 0; pass < 3; ++pass) {
        uint2 u = *(const uint2*)(src + pass * 256);
        if (!valid) { u.x = 0u; u.y = 0u; }
        ucv[pass][j] = u;
      }
    }
#pragma unroll
    for (int pass = 0; pass < 3; ++pass) {
      float acc[4] = {cb[pass].x, cb[pass].y, cb[pass].z, cb[pass].w};
#pragma unroll
      for (int j = 0; j < 5; ++j) {
        float xv[4];
        cv4bf(ucv[pass][j], xv);
        acc[0] += xv[0] * cw[pass][j].x; acc[1] += xv[1] * cw[pass][j].y; acc[2] += xv[2] * cw[pass][j].z; acc[3] += xv[3] * cw[pass][j].w;
      }
#pragma unroll
      for (int e = 0; e < 4; ++e) acc[e] = fsilu(acc[e]);
      if (pass < 2) st4bf(XS + (size_t)R * 512 + pass * 256 + lane * 4, acc);
      else if (lane < 32) st4bf(BM + (size_t)R * 128 + lane * 4, acc);
      else st4bf(CM + (size_t)R * 128 + (lane - 32) * 4, acc);
    }
  }
}

template <int DQK, bool MASK>
DI void attn_stream(const bf16x8* bq, const u16* __restrict__ Kp, int ldk, const u16* __restrict__ VTp, int ldvt, int kt0, int kt1,
                    int qpos, float m2, f32x16* O, float& lsum, int lane) {
  const int r = lane & 31, hh = lane >> 5;
#pragma unroll 2
  for (int kt = kt0; kt < kt1; ++kt) {
    f32x16 s;
#pragma unroll
    for (int i = 0; i < 16; ++i) s[i] = -m2;
#pragma unroll
    for (int ks = 0; ks < DQK / 16; ++ks) {
      bf16x8 ka = *(const bf16x8*)(Kp + (size_t)(kt * 32 + r) * ldk + ks * 16 + hh * 8);
      s = MFMA32(ka, bq[ks], s);
    }
    float pr[16];
#pragma unroll
    for (int i = 0; i < 16; ++i) {
      float x = s[i];
      float e = __builtin_amdgcn_exp2f(x);
      if (MASK) {
        const int kpos = kt * 32 + crow(i, hh);
        const int dd = kpos - qpos;
        if (dd > 128 || dd < -128) e = 0.f;
      }
      pr[i] = e;
      lsum += e;
    }
#pragma unroll
    for (int s2 = 0; s2 < 2; ++s2) {
      bf16x8 pf = pack8(pr + 8 * s2);
#pragma unroll
      for (int dt = 0; dt < 2; ++dt) {
        const u16* vp = VTp + (size_t)(dt * 32 + r) * ldvt + kt * 32 + 16 * s2 + 4 * hh;
        s16x4 lo = *(const s16x4*)vp;
        s16x4 hi = *(const s16x4*)(vp + 8);
        bf16x8 vf = __builtin_shufflevector(lo, hi, 0, 1, 2, 3, 4, 5, 6, 7);
        O[dt] = MFMA32(vf, pf, O[dt]);
      }
    }
  }
}

constexpr int AK_LD = 72, AV_LD = 68, A_STAGE = 64 * AK_LD + 64 * AV_LD;
DI void attnA_gload(u32x4 (&rk)[2], u32x4 (&rv)[2], const u16* __restrict__ Kt, const u16* __restrict__ Vt, int kt) {
#pragma unroll
  for (int j = 0; j < 2; ++j) {
    rk[j] = *(const u32x4*)(Kt + (size_t)(kt * 64 + 32 * j) * 256);
    rv[j] = *(const u32x4*)(Vt + (size_t)(32 * j) * TB + kt * 64);
  }
}
DI void attnA_sstore(const u32x4 (&rk)[2], const u32x4 (&rv)[2], u16* sKt, u16* sVt) {
#pragma unroll
  for (int j = 0; j < 2; ++j) {
    *(u32x4*)(sKt + 32 * j * AK_LD) = rk[j];
    uint2 lo, hi; lo.x = rv[j].x; lo.y = rv[j].y; hi.x = rv[j].z; hi.y = rv[j].w;
    *(uint2*)(sVt + 32 * j * AV_LD) = lo;
    *(uint2*)(sVt + 32 * j * AV_LD + 4) = hi;
  }
}
DI void attnA_compute(const u16* sK, const u16* sV, const bf16x8 (&bq)[2][2], f32x16 (&O)[2][2], float (&ls)[2], float m2, int r, int hh) {
  bf16x8 pf[2][2][2];
  float one = 1.0f;
  asm("" : "+v"(one));
#pragma unroll
  for (int sub = 0; sub < 2; ++sub)
#pragma unroll
    for (int c = 0; c < 2; ++c) {
      f32x16 s;
#pragma unroll
      for (int i = 0; i < 16; ++i) s[i] = -m2;
#pragma unroll
      for (int ks = 0; ks < 2; ++ks) {
        bf16x8 ka = *(const bf16x8*)(sK + (sub * 32 + r) * AK_LD + c * 32 + ks * 16 + hh * 8);
        s = MFMA32(ka, bq[c][ks], s);
      }
      float pr[16];
#pragma unroll
      for (int i = 0; i < 16; ++i) {
        pr[i] = __builtin_amdgcn_exp2f(s[i]);
        if (c == 0) ls[0] += pr[i]; else ls[1] = __builtin_fmaf(pr[i], one, ls[1]);
      }
      pf[c][sub][0] = pack8(pr);
      pf[c][sub][1] = pack8(pr + 8);
    }
#pragma unroll
  for (int sub = 0; sub < 2; ++sub)
#pragma unroll
    for (int s2 = 0; s2 < 2; ++s2)
#pragma unroll
      for (int dt = 0; dt < 2; ++dt) {
        const u16* vp = sV + (dt * 32 + r) * AV_LD + sub * 32 + 16 * s2 + 4 * hh;
        s16x4 lo = *(const s16x4*)vp;
        s16x4 hi = *(const s16x4*)(vp + 8);
        bf16x8 vf = __builtin_shufflevector(lo, hi, 0, 1, 2, 3, 4, 5, 6, 7);
#pragma unroll
        for (int c = 0; c < 2; ++c) O[c][dt] = MFMA32(vf, pf[c][sub][s2], O[c][dt]);
      }
}
DI void attnA_item(const Params& p, int l, int b, int h, int qrow0, int nkeys, char* smem) {
  const int t = opq(threadIdx.x);
  const int lane = t & 63, wave = t >> 6, r = lane & 31, hh = lane >> 5;
  const u16* QA = (const u16*)(p.ws + OFF_QA); const u16* KA = (const u16*)(p.ws + OFF_KA); const u16* VAT = (const u16*)(p.ws + OFF_VAT);
  u16* MIX = (u16*)(p.ws + OFF_H);
  const float* misc = (const float*)(p.ws + OFF_MISC);
  const float lam = misc[l * 4 + 0], lam_init = misc[l * 4 + 1], m2 = misc[l * 4 + 2];
  const int i = qrow0 + wave * 32 + r;
  const size_t R = (size_t)b * TB + i;
  bf16x8 bq[2][2];
#pragma unroll
  for (int c = 0; c < 2; ++c)
#pragma unroll
    for (int ks = 0; ks < 2; ++ks) bq[c][ks] = *(const bf16x8*)(QA + R * 256 + h * 64 + c * 32 + ks * 16 + hh * 8);
  f32x16 O[2][2];
#pragma unroll
  for (int c = 0; c < 2; ++c)
#pragma unroll
    for (int d = 0; d < 2; ++d)
#pragma unroll
      for (int k = 0; k < 16; ++k) O[c][d][k] = 0.f;
  float ls[2] = {0.f, 0.f};
  const int srow = t >> 3, sch = (t & 7) * 8;
  const u16* Kt = KA + ((size_t)b * TB + srow) * 256 + h * 64 + sch;
  const u16* Vt = VAT + ((size_t)b * 256 + h * 64 + srow) * TB + sch;
  u16* sm = (u16*)smem;
  u16* sKt = sm + srow * AK_LD + sch;
  u16* sVt = sm + 64 * AK_LD + srow * AV_LD + sch;
  const int nt = nkeys / 64;
  u32x4 rk0[2], rv0[2], rk1[2], rv1[2];
  __syncthreads();
  attnA_gload(rk0, rv0, Kt, Vt, 0);
  attnA_sstore(rk0, rv0, sKt, sVt);
  attnA_gload(rk1, rv1, Kt, Vt, 1);
  __syncthreads();
  for (int kt = 0; kt < nt; kt += 2) {
    attnA_compute(sm, sm + 64 * AK_LD, bq, O, ls, m2, r, hh);
    attnA_sstore(rk1, rv1, sKt + A_STAGE, sVt + A_STAGE);
    attnA_gload(rk0, rv0, Kt, Vt, min(kt + 2, nt - 1));
    __syncthreads();
    attnA_compute(sm + A_STAGE, sm + A_STAGE + 64 * AK_LD, bq, O, ls, m2, r, hh);
    attnA_sstore(rk0, rv0, sKt, sVt);
    attnA_gload(rk1, rv1, Kt, Vt, min(kt + 3, nt - 1));
    __syncthreads();
  }
  float l0 = ls[0], l1 = ls[1];
  l0 += __shfl_xor(l0, 32);
  l1 += __shfl_xor(l1, 32);
  const float i0 = 1.0f / l0, i1 = lam / l1;
  float o[2][16];
  float ss = 0.f;
#pragma unroll
  for (int d = 0; d < 2; ++d)
#pragma unroll
    for (int k = 0; k < 16; ++k) { o[d][k] = O[0][d][k] * i0 - O[1][d][k] * i1; ss += o[d][k] * o[d][k]; }
  ss += __shfl_xor(ss, 32);
  const float rinv = rsqrtf(ss * (1.0f / 64) + EPS) * (1.0f - lam_init);
  const float* subln = p.in[18] + l * 64;
#pragma unroll
  for (int d = 0; d < 2; ++d)
#pragma unroll
    for (int g = 0; g < 4; ++g) {
      const int dv0 = d * 32 + 8 * g + 4 * hh;
      float vv[4];
#pragma unroll
      for (int e = 0; e < 4; ++e) vv[e] = o[d][4 * g + e] * rinv * subln[dv0 + e];
      st4bf(MIX + R * DM + h * 64 + dv0, vv);
    }
}

DI void attnB_item(const Params& p, int l, int b, int hq, int qb, bool ctxq) {
  const int t_ = opq(threadIdx.x);
  const int lane = t_ & 63, wave = t_ >> 6, r = lane & 31, hh = lane >> 5;
  const u16* QB = (const u16*)(p.ws + OFF_QB); const u16* KB = (const u16*)(p.ws + OFF_KB); const u16* VBT = (const u16*)(p.ws + OFF_VBT);
  u16* MIX = (u16*)(p.ws + OFF_H);
  const float* misc = (const float*)(p.ws + OFF_MISC);
  const float m2 = misc[l * 4 + 3];
  const int kvh = hq >> 1;
  const int tpos0 = qb * 128 + wave * 32;
  const int i = (ctxq ? 0 : NCTX) + tpos0 + r;
  const size_t R = (size_t)b * TB + i;
  bf16x8 bq[4];
#pragma unroll
  for (int ks = 0; ks < 4; ++ks) bq[ks] = *(const bf16x8*)(QB + R * 256 + hq * 64 + ks * 16 + hh * 8);
  f32x16 O[2];
#pragma unroll
  for (int d = 0; d < 2; ++d)
#pragma unroll
    for (int k = 0; k < 16; ++k) O[d][k] = 0.f;
  float ls = 0.f;
  const u16* Kc = KB + (size_t)b * TB * 128 + kvh * 64;
  const u16* Vc = VBT + ((size_t)b * 128 + kvh * 64) * TB;
  if (!ctxq) {
    int lo = tpos0 - 128; if (lo < 0) lo = 0;
    int hi = tpos0 + 32 + 128; if (hi > 8192) hi = 8192;
    attn_stream<64, true>(bq, Kc + (size_t)NCTX * 128, 128, Vc + NCTX, TB, lo / 32, hi / 32, tpos0 + r, m2, O, ls, lane);
  }
  attn_stream<64, false>(bq, Kc, 128, Vc, TB, 0, NCTX / 32, 0, m2, O, ls, lane);
  ls += __shfl_xor(ls, 32);
  ls += __builtin_amdgcn_exp2f(p.in[21][l * 4 + hq] * LOG2E - m2);
  const float inv = 1.0f / ls;
#pragma unroll
  for (int d = 0; d < 2; ++d)
#pragma unroll
    for (int g = 0; g < 4; ++g) {
      const int dv0 = d * 32 + 8 * g + 4 * hh;
      float vv[4];
#pragma unroll
      for (int e = 0; e < 4; ++e) vv[e] = O[d][4 * g + e] * inv;
      st4bf(MIX + R * DM + 256 + hq * 64 + dv0, vv);
    }
}

DI void ssd_cum(const Params& p, int l, int b, int mc, int dir, int h, float* s_dt, float* s_cum, int lane) {
  const float A = -expf(p.in[25][l * 16 + dir * 8 + h]);
  const float* DT = (const float*)(p.ws + OFF_DT);
  const size_t R0 = (size_t)b * TB + mc * 128;
  const float d0 = DT[(R0 + 2 * lane) * 16 + dir * 8 + h];
  const float d1 = DT[(R0 + 2 * lane + 1) * 16 + dir * 8 + h];
  const float a0 = d0 * A, a1 = d1 * A, ps = a0 + a1;
  float inc = ps;
#pragma unroll
  for (int off = 1; off < 64; off <<= 1) {
    float v = __shfl_up(inc, off);
    if (lane >= off) inc += v;
  }
  const float pre0 = inc - ps + a0, pre1 = inc;
  float c0 = pre0, c1 = pre1;
  if (dir == 1) {
    const float tot = __shfl(inc, 63);
    c0 = tot - pre0 + a0;
    c1 = tot - pre1 + a1;
  }
  s_dt[2 * lane] = d0; s_dt[2 * lane + 1] = d1;
  s_cum[2 * lane] = c0; s_cum[2 * lane + 1] = c1;
}
DI int proc_chunk(int mc, int dir) { return dir == 0 ? mc : (mc < 2 ? 1 - mc : 67 - mc); }

DI void stage_xsT(const Params& p, int b, int mc, int h, u16* sXT, int t) {
  const int ll = t & 127, half = t >> 7;
  const u16* XS = (const u16*)(p.ws + OFF_XS);
  const u16* src = XS + ((size_t)b * TB + mc * 128 + ll) * 512 + h * 64 + half * 32;
#pragma unroll
  for (int c = 0; c < 4; ++c) {
    uint4 u = *(const uint4*)(src + c * 8);
    const int p0 = half * 32 + c * 8;
    sXT[(p0 + 0) * 136 + ll] = (u16)(u.x & 0xffff); sXT[(p0 + 1) * 136 + ll] = (u16)(u.x >> 16);
    sXT[(p0 + 2) * 136 + ll] = (u16)(u.y & 0xffff); sXT[(p0 + 3) * 136 + ll] = (u16)(u.y >> 16);
    sXT[(p0 + 4) * 136 + ll] = (u16)(u.z & 0xffff); sXT[(p0 + 5) * 136 + ll] = (u16)(u.z >> 16);
    sXT[(p0 + 6) * 136 + ll] = (u16)(u.w & 0xffff); sXT[(p0 + 7) * 136 + ll] = (u16)(u.w >> 16);
  }
}

DI void ssd1_item(const Params& p, int l, int b, int mc, int h, char* smem) {
  u16* sXT = (u16*)smem;
  u16* sBT = sXT + 64 * 136;
  float* s_dt = (float*)(sBT + 2 * 64 * 136);
  float* s_cum = s_dt + 256;
  const int t = opq(threadIdx.x), lane = t & 63, wave = t >> 6, r = lane & 31, hh = lane >> 5;
  const int g = h >> 2;
  if (wave < 2) ssd_cum(p, l, b, mc, wave, h, s_dt + wave * 128, s_cum + wave * 128, lane);
  __syncthreads();
  stage_xsT(p, b, mc, h, sXT, t);
  {
    const int ll = t & 127, half = t >> 7;
    const u16* BM = (const u16*)(p.ws + OFF_BM);
    const u16* src = BM + ((size_t)b * TB + mc * 128 + ll) * 128 + g * 64 + half * 32;
    const float w0 = s_dt[ll] * fexp(s_cum[127] - s_cum[ll]);
    const float w1 = s_dt[128 + ll] * fexp(s_cum[128 + 0] - s_cum[128 + ll]);
#pragma unroll
    for (int c = 0; c < 4; ++c) {
      uint4 u = *(const uint4*)(src + c * 8);
      unsigned uu[4] = {u.x, u.y, u.z, u.w};
      const int n0 = half * 32 + c * 8;
#pragma unroll
      for (int e = 0; e < 4; ++e) {
        float lo = bflo(uu[e]), hi = bfhi(uu[e]);
        sBT[(n0 + 2 * e) * 136 + ll] = f2bf(lo * w0);
        sBT[(n0 + 2 * e + 1) * 136 + ll] = f2bf(hi * w0);
        sBT[64 * 136 + (n0 + 2 * e) * 136 + ll] = f2bf(lo * w1);
        sBT[64 * 136 + (n0 + 2 * e + 1) * 136 + ll] = f2bf(hi * w1);
      }
    }
  }
  __syncthreads();
  {
    const int dir = wave >> 1, pt = wave & 1;
    f32x16 acc[2];
#pragma unroll
    for (int n = 0; n < 2; ++n)
#pragma unroll
      for (int k = 0; k < 16; ++k) acc[n][k] = 0.f;
    const u16* bt = sBT + dir * 64 * 136;
#pragma unroll
    for (int ks = 0; ks < 8; ++ks) {
      bf16x8 af = *(const bf16x8*)(sXT + (pt * 32 + r) * 136 + ks * 16 + hh * 8);
#pragma unroll
      for (int nt = 0; nt < 2; ++nt) {
        bf16x8 bfr = *(const bf16x8*)(bt + (nt * 32 + r) * 136 + ks * 16 + hh * 8);
        acc[nt] = MFMA32(af, bfr, acc[nt]);
      }
    }
    const int pc = proc_chunk(mc, dir);
    float* ST = (float*)(p.ws + OFF_R1) + ((size_t)(((b * 2 + dir) * 8 + h) * 66 + pc)) * 4096;
#pragma unroll
    for (int nt = 0; nt < 2; ++nt)
#pragma unroll
      for (int k = 0; k < 16; ++k) ST[(pt * 32 + crow(k, hh)) * 64 + nt * 32 + r] = acc[nt][k];
    if (lane == 0 && pt == 0) ((float*)(p.ws + OFF_ATOT))[((b * 2 + dir) * 8 + h) * 66 + pc] = s_cum[dir * 128 + (dir == 0 ? 127 : 0)];
  }
  __syncthreads();
}

DI void ssd2_phase(const Params& p, int bid, int nb) {
  float* ST = (float*)(p.ws + OFF_R1);
  const float* AT = (const float*)(p.ws + OFF_ATOT);
  const int t_ = opq(threadIdx.x);
  for (int gid = bid * 256 + t_; gid < 32 * 4096; gid += nb * 256) {
    const int bdh = gid >> 12, e = gid & 4095;
    float* base = ST + (size_t)bdh * 66 * 4096 + e;
    const float* at = AT + bdh * 66;
    float prev = 0.f;
    for (int pc0 = 0; pc0 < 66; pc0 += 33) {
      float loc[33];
#pragma unroll
      for (int j = 0; j < 33; ++j) loc[j] = base[(size_t)(pc0 + j) * 4096];
#pragma unroll
      for (int j = 0; j < 33; ++j) {
        const float dec = fexp(at[pc0 + j]);
        base[(size_t)(pc0 + j) * 4096] = prev;
        prev = dec * prev + loc[j];
      }
    }
  }
}

DI void ssd3_item(const Params& p, int l, int b, int mc, int g, int th, char* smem) {
  u16* sB = (u16*)smem;
  u16* sXT = sB + 128 * 72;
  float* s_dt = (float*)(sXT + 2 * 64 * 136);
  float* s_cum = s_dt + 8 * 128;
  float* s_red = s_cum + 8 * 128;
  const int t = opq(threadIdx.x), lane = t & 63, wave = t >> 6, r = lane & 31, hh = lane >> 5;
  const int tsub = wave & 1, hpair = wave >> 1;
  const u16* BM = (const u16*)(p.ws + OFF_BM); const u16* CM = (const u16*)(p.ws + OFF_CM);
  const u16* Z = (const u16*)(p.ws + OFF_Z);
  u16* MIX = (u16*)(p.ws + OFF_H);
  __syncthreads();
#pragma unroll
  for (int q = 0; q < 2; ++q) {
    const int hd = wave * 2 + q;
    ssd_cum(p, l, b, mc, hd & 1, g * 4 + (hd >> 1), s_dt + hd * 128, s_cum + hd * 128, lane);
  }
  {
    const int row = t >> 1, half = t & 1;
    const u16* src = BM + ((size_t)b * TB + mc * 128 + row) * 128 + g * 64 + half * 32;
#pragma unroll
    for (int c = 0; c < 4; ++c) *(u32x4*)(sB + row * 72 + half * 32 + c * 8) = *(const u32x4*)(src + c * 8);
  }
  const int ltok = th * 64 + tsub * 32 + r;
  const size_t R = (size_t)b * TB + mc * 128 + ltok;
  bf16x8 cf[4];
#pragma unroll
  for (int ks = 0; ks < 4; ++ks) cf[ks] = *(const bf16x8*)(CM + R * 128 + g * 64 + ks * 16 + hh * 8);
  float ssq = 0.f;
#pragma unroll 1
  for (int hl2 = 0; hl2 < 2; ++hl2) {
    __syncthreads();
    stage_xsT(p, b, mc, g * 4 + hl2, sXT, t);
    stage_xsT(p, b, mc, g * 4 + 2 + hl2, sXT + 64 * 136, t);
    __syncthreads();
    const int hl = hpair * 2 + hl2, h = g * 4 + hl;
    const u16* myXT = sXT + hpair * 64 * 136;
    const float dskip = p.in[26][l * 8 + h];
    f32x16 Y[2];
#pragma unroll
    for (int pt = 0; pt < 2; ++pt)
#pragma unroll
      for (int k = 0; k < 16; ++k) Y[pt][k] = 0.f;
#pragma unroll 1
    for (int dir = 0; dir < 2; ++dir) {
      const float cl = s_cum[(hl * 2 + dir) * 128 + ltok];
      const int pc = proc_chunk(mc, dir);
      const float* Sp = (const float*)(p.ws + OFF_R1) + ((size_t)(((b * 2 + dir) * 8 + h) * 66 + pc)) * 4096;
      f32x16 yo[2];
#pragma unroll
      for (int pt = 0; pt < 2; ++pt)
#pragma unroll
        for (int k = 0; k < 16; ++k) yo[pt][k] = 0.f;
#pragma unroll
      for (int ks = 0; ks < 4; ++ks)
#pragma unroll
        for (int pt = 0; pt < 2; ++pt) {
          const float4* sp4 = (const float4*)(Sp + (pt * 32 + r) * 64 + ks * 16 + hh * 8);
          float4 x0 = sp4[0], x1 = sp4[1];
          float tmp[8] = {x0.x, x0.y, x0.z, x0.w, x1.x, x1.y, x1.z, x1.w};
          bf16x8 sf = pack8(tmp);
          yo[pt] = MFMA32(sf, cf[ks], yo[pt]);
        }
      const float ecl = fexp(cl);
#pragma unroll
      for (int pt = 0; pt < 2; ++pt)
#pragma unroll
        for (int k = 0; k < 16; ++k) Y[pt][k] += ecl * yo[pt][k];
    }
#pragma unroll 1
    for (int st = 0; st < 4; ++st) {
      f32x16 cbt;
#pragma unroll
      for (int k = 0; k < 16; ++k) cbt[k] = 0.f;
#pragma unroll
      for (int ks = 0; ks < 4; ++ks) {
        bf16x8 bfrag = *(const bf16x8*)(sB + (st * 32 + r) * 72 + ks * 16 + hh * 8);
        cbt = MFMA32(bfrag, cf[ks], cbt);
      }
#pragma unroll
      for (int dir = 0; dir < 2; ++dir) {
        const float* cumv = s_cum + (hl * 2 + dir) * 128;
        const float* dtv = s_dt + (hl * 2 + dir) * 128;
        const float cl = cumv[ltok];
        float m[16];
#pragma unroll
        for (int k = 0; k < 16; ++k) {
          const int s = st * 32 + crow(k, hh);
          const bool valid = (dir == 0) ? (s <= ltok) : (s >= ltok);
          float val = valid ? cbt[k] * fexp(cl - cumv[s]) * dtv[s] : 0.f;
          if (dir == 0 && s == ltok) val += dskip;
          m[k] = val;
        }
#pragma unroll
        for (int s2 = 0; s2 < 2; ++s2) {
          bf16x8 pf = pack8(m + 8 * s2);
#pragma unroll
          for (int pt = 0; pt < 2; ++pt) {
            const u16* xp = myXT + (pt * 32 + r) * 136 + st * 32 + 16 * s2 + 4 * hh;
            s16x4 lo = *(const s16x4*)xp;
            s16x4 hi = *(const s16x4*)(xp + 8);
            bf16x8 xf = __builtin_shufflevector(lo, hi, 0, 1, 2, 3, 4, 5, 6, 7);
            Y[pt] = MFMA32(xf, pf, Y[pt]);
          }
        }
      }
    }
#pragma unroll
    for (int pt = 0; pt < 2; ++pt)
#pragma unroll
      for (int gq = 0; gq < 4; ++gq) {
        const int ch0 = h * 64 + pt * 32 + 8 * gq + 4 * hh;
        float zv[4];
        ld4bf(Z + R * 512 + ch0, zv);
        float yv[4];
#pragma unroll
        for (int e = 0; e < 4; ++e) { yv[e] = Y[pt][4 * gq + e] * fsilu(zv[e]); ssq += yv[e] * yv[e]; }
        st4bf(MIX + R * DM + 512 + ch0, yv);
      }
  }
  ssq += __shfl_xor(ssq, 32);
  if (hh == 0) s_red[wave * 32 + r] = ssq;
  __syncthreads();
  ssq += s_red[(wave ^ 2) * 32 + r];
  const float rinv = rsqrtf(ssq * (1.0f / 256) + EPS);
  const float* gn = p.in[27] + l * 512;
  for (int hl2 = 0; hl2 < 2; ++hl2) {
    const int h = g * 4 + hpair * 2 + hl2;
#pragma unroll
    for (int pt = 0; pt < 2; ++pt)
#pragma unroll
      for (int gq = 0; gq < 4; ++gq) {
        const int ch0 = h * 64 + pt * 32 + 8 * gq + 4 * hh;
        float yv[4];
        ld4bf(MIX + R * DM + 512 + ch0, yv);
#pragma unroll
        for (int e = 0; e < 4; ++e) yv[e] = yv[e] * rinv * gn[ch0 + e];
        st4bf(MIX + R * DM + 512 + ch0, yv);
      }
  }
}

__global__ void __launch_bounds__(256, 2) fwd_megakernel(Params p) {
  __shared__ __attribute__((aligned(16))) char smem[73728];
  __shared__ uint4 xb_words;
  cg::grid_group grid = cg::this_grid();
  const int bid = blockIdx.x, nb = gridDim.x;
  unsigned* bar = (unsigned*)(p.ws + OFF_BAR);
  if (threadIdx.x == 0) xb_words = make_uint4(0u, 0u, 0u, 0u);
  __syncthreads();
  const XcdBarrier xb = xcd_barrier_post(bar, (volatile LAS unsigned*)&xb_words);
  if (p.ws == nullptr) grid.sync();

  for (int it = bid; it < CV_T5 + 1152 + 1; it += nb) {
    if (it < CV_T5) convert_item(p, 0, it, smem);
    else if (it < CV_T5 + 1152) mods_item(p, it - CV_T5, smem);
    else misc_item(p);
  }
  xcd_barrier(xb);

  for (int l = 0; l < 2; ++l) {
    const bool last = (l == 1);
    if (l == 1) {
      for (int it = bid; it < CV_T5; it += nb) convert_item(p, 1, it, smem);
    }
    normmod_phase(p, l, 0, bid, nb);
    xcd_barrier(xb);
    gemm_phase<0>(p, l, (const u16*)(p.ws + OFF_H), 1024, (const u16*)(p.ws + OFF_W13A), 44, 0.f, 0, smem, bid, nb);
    xcd_barrier(xb);
    gemm_phase<1>(p, l, (const u16*)(p.ws + OFF_R1), 2816, (const u16*)(p.ws + OFF_W2A), 8, 0.5f, 2, smem, bid, nb);
    xcd_barrier(xb);
    normmod_phase(p, l, 1, bid, nb);
    xcd_barrier(xb);
    gemm_phase<2>(p, l, (const u16*)(p.ws + OFF_H), 1024, (const u16*)(p.ws + OFF_WIN), 21, 0.f, 0, smem, bid, nb);
    xcd_barrier(xb);
    postproc_phase(p, l, bid, nb);
    xcd_barrier(xb);
    {
      const int nA = 512, nB = 512, nS = 1056, nAc = last ? 0 : 16, nBc = last ? 0 : 16;
      const int tot = nA + nB + nS + nAc + nBc;
      for (int it0 = bid; it0 < tot; it0 += nb) {
        int j = it0;
        if (j < nA + nB) j = (j & ~511) | ((j & 7) << 6) | ((j >> 3) & 63);
        if (j < nA) { attnA_item(p, l, j >> 8, (j >> 6) & 3, NCTX + (j & 63) * 128, TB, smem); continue; }
        j -= nA;
        if (j < nB) { attnB_item(p, l, j >> 8, (j >> 6) & 3, j & 63, false); continue; }
        j -= nB;
        if (j < nS) { ssd1_item(p, l, j / 528, (j % 528) >> 3, j & 7, smem); continue; }
        j -= nS;
        if (j < nAc) { attnA_item(p, l, j >> 3, (j >> 1) & 3, (j & 1) * 128, NCTX, smem); continue; }
        j -= nAc;
        attnB_item(p, l, j >> 3, (j >> 1) & 3, j & 1, true);
      }
    }
    xcd_barrier(xb);
    ssd2_phase(p, bid, nb);
    xcd_barrier(xb);
    {
      const int skip = last ? 8 : 0;
      for (int it = bid; it < 2 * (264 - skip); it += nb) {
        const int b = it / (264 - skip), rem = it % (264 - skip) + skip, mc = rem >> 2, g = (rem >> 1) & 1, th = rem & 1;
        ssd3_item(p, l, b, mc, g, th, smem);
      }
    }
    xcd_barrier(xb);
    gemm_phase<1>(p, l, (const u16*)(p.ws + OFF_H), 1024, (const u16*)(p.ws + OFF_WOUT), 8, 1.0f, 5, smem, bid, nb);
    xcd_barrier(xb);
    normmod_phase(p, l, 2, bid, nb);
    xcd_barrier(xb);
    gemm_phase<0>(p, l, (const u16*)(p.ws + OFF_H), 1024, (const u16*)(p.ws + OFF_W13B), 44, 0.f, 0, smem, bid, nb);
    xcd_barrier(xb);
    gemm_phase<1>(p, l, (const u16*)(p.ws + OFF_R1), 2816, (const u16*)(p.ws + OFF_W2B), 8, 0.5f, 8, smem, bid, nb);
    if (!last) xcd_barrier(xb);
  }
}

extern "C" void kernel_launch(void* const* d_in, const int* in_sizes, int n_in, void* d_out, int out_size,
                              void* d_ws, size_t ws_size, hipStream_t stream) {
  static int grid_blocks = 0;
  if (!grid_blocks) {
    int dev = 0, cus = 0, per_cu = 0;
    (void)hipGetDevice(&dev);
    (void)hipDeviceGetAttribute(&cus, hipDeviceAttributeMultiprocessorCount, dev);
    (void)hipOccupancyMaxActiveBlocksPerMultiprocessor(&per_cu, fwd_megakernel, 256, 0);
    if (per_cu > 2) per_cu = 2;
    if (per_cu < 1) per_cu = 1;
    grid_blocks = cus * per_cu;
  }
  if (ws_size < WS_TOTAL) { fprintf(stderr, "workspace too small: %zu < %zu\n", ws_size, (size_t)WS_TOTAL); return; }
  Params p{};
  for (int i = 0; i < 31; ++i) p.in[i] = (const float*)d_in[i];
  p.out = (float*)d_out;
  p.ws = (char*)d_ws;
  (void)hipMemsetAsync((char*)d_ws + OFF_BAR, 0, XCD_BAR_WORDS * sizeof(unsigned), stream);
  void* args[] = {&p};
  hipError_t e = hipLaunchCooperativeKernel((void*)fwd_megakernel, dim3(grid_blocks), dim3(256), args, 0, stream);
  if (e != hipSuccess) fprintf(stderr, "cooperative launch failed: %s (grid %d)\n", hipGetErrorString(e), grid_blocks);
}
```
